# Optimizing an MI355X kernel written in HIP

```python
import jax, jax.numpy as jnp
from jax import lax
import numpy as np

D_MODEL = 1024
BATCH = 8
SEQ = 2048
DEPTH = 4
DEC_BATCH = 128
DEC_SEQ = 4
PAST_LEN = 16384
PAGE_SIZE = 128

N_META = 16
W_A = D_MODEL // 2
W_B = D_MODEL - W_A
A_HEADS = 8
A_HEAD_DIM = W_A // A_HEADS
CONV_W = 4
RG_C = 8.0
B_HEADS = 4
B_DK = W_B // B_HEADS
B_DV = W_B // B_HEADS
CHUNK = 64
D_FF = 4 * D_MODEL
IN_COLS = 2 * W_A + 4 * W_B
EPS = 1e-6
F_MIN = 1e-30

kernel_name = "hymba_rglru_hgrn2_decoder_step"


def _rms(x):
    x32 = x.astype(jnp.float32)
    return x32 * lax.rsqrt(jnp.mean(x32 * x32, axis=-1, keepdims=True) + EPS)


def _rmsnorm(x, g):
    return (_rms(x) * g.astype(jnp.float32)).astype(x.dtype)


def _lin_combine(c1, c2):
    a1, b1 = c1
    a2, b2 = c2
    return a1 * a2, a2 * b1 + b2


def _hgrn2_chunk(S, q, k, v, logf):
    C = q.shape[2]
    b = jnp.cumsum(logf, axis=2)
    inter = jnp.einsum('bhck,bhkv->bhcv', q * jnp.exp(b), S)
    diff = b[:, :, :, None, :] - b[:, :, None, :, :]
    mask = jnp.tril(jnp.ones((C, C), dtype=bool))[:, :, None]
    decay = jnp.exp(jnp.where(mask, diff, 0.0)) * mask.astype(diff.dtype)
    A = jnp.einsum('bhtk,bhtsk,bhsk->bhts', q, decay, k)
    intra = jnp.einsum('bhts,bhsv->bhtv', A, v)
    b_last = b[:, :, -1:, :]
    S_new = S * jnp.exp(b_last[:, :, 0, :])[..., None] + jnp.einsum(
        'bhsk,bhsv->bhkv', k * jnp.exp(b_last - b), v)
    return S_new, inter + intra


def _hgrn2(q, k, v, logf, S0, first_len):
    Bn, H, T, _ = q.shape
    S, o_first = _hgrn2_chunk(S0, q[:, :, :first_len], k[:, :, :first_len],
                              v[:, :, :first_len], logf[:, :, :first_len])
    rest = T - first_len
    if rest == 0:
        return o_first, S
    n = rest // CHUNK

    def split(z):
        return jnp.moveaxis(z[:, :, first_len:].reshape(Bn, H, n, CHUNK, z.shape[-1]), 2, 0)

    S, o_rest = lax.scan(lambda s, xs: _hgrn2_chunk(s, *xs), S,
                         (split(q), split(k), split(v), split(logf)))
    o_rest = jnp.moveaxis(o_rest, 0, 2).reshape(Bn, H, rest, v.shape[-1])
    return jnp.concatenate([o_first, o_rest], axis=2), S


def _mixer(hn, conv_buf, h0, S0, w_in, conv_w, conv_b, w_ra, b_ra, w_rx, b_rx,
           lam, lb, gn, w_out, first_len):
    Bn, T, _ = hn.shape
    f32 = jnp.float32
    u = (hn @ w_in).astype(f32)
    xa, ga, qb, fb, ib, gb = jnp.split(
        u, [W_A, 2 * W_A, 2 * W_A + W_B, 2 * W_A + 2 * W_B, 2 * W_A + 3 * W_B], axis=-1)
    xpad = jnp.concatenate([conv_buf.astype(f32), xa], axis=1)
    cw = conv_w.astype(f32)
    xc = conv_b.astype(f32) + sum(xpad[:, j:j + T] * cw[j] for j in range(CONV_W))
    new_conv = xpad[:, T:]
    xh = xc.reshape(Bn, T, A_HEADS, A_HEAD_DIM)
    r = jax.nn.sigmoid(jnp.einsum('bthi,hij->bthj', xh, w_ra.astype(f32)) + b_ra).reshape(Bn, T, W_A)
    ig = jax.nn.sigmoid(jnp.einsum('bthi,hij->bthj', xh, w_rx.astype(f32)) + b_rx).reshape(Bn, T, W_A)
    log_a = -RG_C * r * jax.nn.softplus(-lam.astype(f32))
    a = jnp.exp(log_a)
    bt = jnp.sqrt(-jnp.expm1(2.0 * log_a)) * ig * xc
    bt = bt.at[:, 0].add(a[:, 0] * h0.astype(f32))
    _, hs = lax.associative_scan(_lin_combine, (a, bt), axis=1)
    y_a = hs * jax.nn.gelu(ga)
    h_new = hs[:, -1]
    def heads(z):
        return z.reshape(Bn, T, B_HEADS, -1).transpose(0, 2, 1, 3)
    q = heads(jax.nn.silu(qb)) * (B_DK ** -0.5)
    lbh = lb.astype(f32).reshape(B_HEADS, 1, B_DK)
    fpre = heads(fb)
    f = lbh + (1.0 - lbh) * jax.nn.sigmoid(fpre)
    logf = jnp.log(jnp.maximum(f, F_MIN))
    k = (1.0 - lbh) * jax.nn.sigmoid(-fpre)
    v = heads(ib)
    o, S_new = _hgrn2(q, k, v, logf, S0.astype(f32), first_len)
    o = o.transpose(0, 2, 1, 3)
    o = _rms(o) * gn.astype(f32) * jax.nn.silu(gb.reshape(Bn, T, B_HEADS, B_DV))
    y = jnp.concatenate([y_a, o.reshape(Bn, T, W_B)], axis=-1)
    return (y.astype(hn.dtype) @ w_out), new_conv, h_new, S_new


def setup_inputs(seed: int = 0) -> dict:
    key = jax.random.key(seed)
    ks = jax.random.split(key, 24)
    nrm = jax.random.normal
    f32 = jnp.float32
    u_a = jax.random.uniform(ks[13], (DEPTH, W_A), f32, 0.9, 0.999)
    return {
        "x_prompt": nrm(ks[0], (BATCH, SEQ, D_MODEL), f32),
        "x_sample": nrm(ks[1], (DEC_BATCH, DEC_SEQ, D_MODEL), f32),
        "state_rglru_h": 0.5 * nrm(ks[2], (DEPTH, DEC_BATCH, W_A), f32),
        "state_rglru_conv": nrm(ks[3], (DEPTH, DEC_BATCH, CONV_W - 1, W_A), f32),
        "state_hgrn2": 0.3 * nrm(ks[4], (DEPTH, DEC_BATCH, B_HEADS, B_DK, B_DV), f32),
        "meta_tokens": nrm(ks[5], (N_META, D_MODEL), f32),
        "ln_mix": 1.0 + 0.02 * nrm(ks[6], (DEPTH, D_MODEL), f32),
        "w_in": nrm(ks[7], (DEPTH, D_MODEL, IN_COLS), f32) * D_MODEL ** -0.5,
        "conv_w": nrm(ks[8], (DEPTH, CONV_W, W_A), f32) * CONV_W ** -0.5,
        "conv_b": 0.02 * nrm(ks[9], (DEPTH, W_A), f32),
        "w_rg_a": nrm(ks[10], (DEPTH, A_HEADS, A_HEAD_DIM, A_HEAD_DIM), f32) * A_HEAD_DIM ** -0.5,
        "b_rg_a": 0.02 * nrm(ks[11], (DEPTH, A_HEADS, A_HEAD_DIM), f32),
        "w_rg_x": nrm(ks[12], (DEPTH, A_HEADS, A_HEAD_DIM, A_HEAD_DIM), f32) * A_HEAD_DIM ** -0.5,
        "b_rg_x": 0.02 * nrm(ks[14], (DEPTH, A_HEADS, A_HEAD_DIM), f32),
        "rg_lambda": jnp.log(u_a / (1.0 - u_a)),
        "hgrn_lb": 0.5 * nrm(ks[15], (DEPTH, W_B), f32),
        "hgrn_norm": 1.0 + 0.02 * nrm(ks[16], (DEPTH, B_DV), f32),
        "w_out": nrm(ks[17], (DEPTH, D_MODEL, D_MODEL), f32) * D_MODEL ** -0.5,
        "ln_mlp": 1.0 + 0.02 * nrm(ks[18], (DEPTH, D_MODEL), f32),
        "w_up": nrm(ks[19], (DEPTH, D_MODEL, D_FF), f32) * D_MODEL ** -0.5,
        "w_down": nrm(ks[20], (DEPTH, D_FF, D_MODEL), f32) * D_FF ** -0.5,
        "ln_final": 1.0 + 0.02 * nrm(ks[21], (D_MODEL,), f32),
    }


def reference(x_prompt, x_sample, state_rglru_h, state_rglru_conv, state_hgrn2,
              meta_tokens, ln_mix, w_in, conv_w, conv_b, w_rg_a, b_rg_a, w_rg_x, b_rg_x,
              rg_lambda, hgrn_lb, hgrn_norm, w_out, ln_mlp, w_up, w_down, ln_final):
    f32 = jnp.float32
    lbs = jax.nn.softmax(hgrn_lb.astype(f32), axis=0)
    lb_all = jnp.clip(jnp.cumsum(lbs, axis=0) - lbs[0], 0.0, 1.0)

    meta = jnp.broadcast_to(meta_tokens.astype(x_prompt.dtype), (BATCH, N_META, D_MODEL))
    xp = jnp.concatenate([meta, x_prompt], axis=1)
    xs = x_sample
    p_conv = jnp.zeros((BATCH, CONV_W - 1, W_A), f32)
    p_h = jnp.zeros((BATCH, W_A), f32)
    p_S = jnp.zeros((BATCH, B_HEADS, B_DK, B_DV), f32)

    ph_l, pc_l, pS_l, sh_l, sc_l, sS_l = [], [], [], [], [], []
    for l in range(DEPTH):
        wl = (w_in[l], conv_w[l], conv_b[l], w_rg_a[l], b_rg_a[l], w_rg_x[l], b_rg_x[l],
              rg_lambda[l], lb_all[l], hgrn_norm[l], w_out[l])
        mp, cp, hp, Sp = _mixer(_rmsnorm(xp, ln_mix[l]), p_conv, p_h, p_S, *wl, N_META)
        ms, cs, hs, Ss = _mixer(_rmsnorm(xs, ln_mix[l]), state_rglru_conv[l], state_rglru_h[l],
                                state_hgrn2[l], *wl, xs.shape[1])
        xp = xp + mp
        xs = xs + ms
        pn = _rmsnorm(xp, ln_mlp[l])
        xp = xp + jnp.square(jax.nn.relu(pn @ w_up[l])) @ w_down[l]
        sn = _rmsnorm(xs, ln_mlp[l])
        xs = xs + jnp.square(jax.nn.relu(sn @ w_up[l])) @ w_down[l]
        ph_l.append(hp); pc_l.append(cp); pS_l.append(Sp)
        sh_l.append(hs); sc_l.append(cs); sS_l.append(Ss)

    y_prompt = _rmsnorm(xp, ln_final)[:, N_META:]
    y_sample = _rmsnorm(xs, ln_final)
    return (y_prompt, y_sample, jnp.stack(ph_l), jnp.stack(pc_l), jnp.stack(pS_l),
            jnp.stack(sh_l), jnp.stack(sc_l), jnp.stack(sS_l))
```

```cpp
#include <hip/hip_runtime.h>
#include <hip/hip_cooperative_groups.h>
#include <cstdio>
namespace cg = cooperative_groups;
#define SKIPI 0

typedef unsigned short bf16_t;
typedef short bf16x8 __attribute__((ext_vector_type(8)));
typedef float f32x4 __attribute__((ext_vector_type(4)));
typedef unsigned u32x4 __attribute__((ext_vector_type(4)));

constexpr int D = 1024, TP = 2064, NB = 8, MP = NB * TP, MS = 512, MT = MP + MS, DEPTH = 4;
constexpr int INC = 3072, DFF = 4096, NCH = 33, SEQ = 2048, NMETA = 16;
constexpr int LDT = 80;
constexpr int LDQ = 144;
constexpr int SMEM_BYTES = 76800;
constexpr int SMEM_ALLOC = SMEM_BYTES + 16;
constexpr float EPSN = 1e-6f;

constexpr size_t O_YP = 0, O_YS = 16777216, O_HP = 17301504, O_CP = 17317888, O_SP = 17367040,
                 O_HS = 19464192, O_CS = 19726336, O_SS = 20512768;

struct Params {
  const float *x_prompt, *x_sample, *st_h, *st_conv, *st_S, *meta, *ln_mix, *w_in, *conv_w, *conv_b,
      *w_ra, *b_ra, *w_rx, *b_rx, *lam, *hgrn_lb, *gn, *w_out, *ln_mlp, *w_up, *w_down, *ln_final;
  float* out;
  bf16_t *Wt_in, *Wt_out, *Wt_up, *Wt_down, *Wg;
  float *lb_all, *SS;
  bf16_t *Xb, *UH, *Y;
  bf16_t *Pc, *Hl;
  float* carry;
  bf16_t* Sbuf;
  float* dec;
  unsigned* bar;
};

__device__ __forceinline__ int otid() { int t = threadIdx.x; asm volatile("" : "+v"(t)); return t; }
__device__ __forceinline__ float bf2f(bf16_t h) { return __uint_as_float(((unsigned)h) << 16); }
typedef float f32x2 __attribute__((ext_vector_type(2)));
typedef __bf16 bf16v2 __attribute__((ext_vector_type(2)));
__device__ __forceinline__ unsigned pk2(float lo, float hi) {
  const f32x2 v = {lo, hi};
  return __builtin_bit_cast(unsigned, __builtin_convertvector(v, bf16v2));
}
__device__ __forceinline__ bf16_t f2bf(float f) { return (bf16_t)(pk2(f, 0.f) & 0xffffu); }
__device__ __forceinline__ float frcp(float x) { return __builtin_amdgcn_rcpf(x); }
__device__ __forceinline__ float sigm(float x) { return frcp(1.f + __expf(-x)); }
__device__ __forceinline__ float silu(float x) { return x * sigm(x); }
__device__ __forceinline__ float gelu_t(float x) {
  float u = 0.7978845608028654f * (x + 0.044715f * x * x * x);
  return x * sigm(2.f * u);
}
__device__ __forceinline__ f32x4 mfma16(bf16x8 a, bf16x8 b, f32x4 c) {
  return __builtin_amdgcn_mfma_f32_16x16x32_bf16(a, b, c, 0, 0, 0);
}
__device__ __forceinline__ uint4 pack8(const float* v) {
  uint4 r;
  r.x = pk2(v[0], v[1]); r.y = pk2(v[2], v[3]); r.z = pk2(v[4], v[5]); r.w = pk2(v[6], v[7]);
  return r;
}


#define XB_TMO      128
#define XB_XCNT(j)  (256  + 64 * (j))
#define XB_XSUB(j)  (1280 + 64 * (j))
#define XB_XGEN(j)  (2304 + 64 * (j))
#define XB_TOP      3328
#define XB_TOPGEN   3392
#define XCD_BAR_WORDS 3456
#define XB_SPIN_CAP (1u << 20)
#define LAS __attribute__((address_space(3)))
__device__ __forceinline__ unsigned xb_ld(unsigned* p) { return __hip_atomic_load(p, __ATOMIC_RELAXED, __HIP_MEMORY_SCOPE_AGENT); }
__device__ __forceinline__ unsigned xb_add(unsigned* p, unsigned v) { return __hip_atomic_fetch_add(p, v, __ATOMIC_RELAXED, __HIP_MEMORY_SCOPE_AGENT); }
__device__ __forceinline__ unsigned xb_xcc_id() { return (unsigned)__builtin_amdgcn_s_getreg((3 << 11) | 20) & 0xFu; }
#define XB_SPIN(cond, bar) do { unsigned _sp = 0; while (cond) { __builtin_amdgcn_s_sleep(1); \
    if ((++_sp & 255u) == 0u) { if (xb_ld(&(bar)[XB_TMO])) break; if (_sp > XB_SPIN_CAP) { atomicAdd(&(bar)[XB_TMO], 1u); break; } } } } while (0)
struct XcdBarrier { unsigned* bar; unsigned x; volatile LAS unsigned* st; };
__device__ __forceinline__ XcdBarrier xcd_barrier_post(unsigned* bar, volatile LAS unsigned* st) {
  XcdBarrier b; b.bar = bar; b.x = xb_xcc_id(); b.st = st;
  if (threadIdx.x == 0) (void)xb_add(&bar[XB_XCNT(b.x)], 1u);
  return b;
}
__device__ __forceinline__ void xcd_barrier_complete(unsigned* bar, unsigned x, unsigned& nloc, unsigned& nx) {
  const unsigned G = gridDim.x * gridDim.y * gridDim.z;
  unsigned sum, cnt, mine, sp = 0u;
  for (;;) {
    sum = 0u; cnt = 0u; mine = 0u;
#pragma unroll
    for (unsigned j = 0; j < 16; ++j) { const unsigned c = xb_ld(&bar[XB_XCNT(j)]); sum += c; cnt += (c > 0u) ? 1u : 0u; mine = (j == x) ? c : mine; }
    if (sum == G) break;
    __builtin_amdgcn_s_sleep(1);
    if ((++sp & 255u) == 0u) { if (xb_ld(&bar[XB_TMO])) break; if (sp > XB_SPIN_CAP) { atomicAdd(&bar[XB_TMO], 1u); break; } }
  }
  nloc = mine > 0u ? mine : 1u; nx = cnt > 0u ? cnt : 1u;
}
__device__ __forceinline__ void xcd_barrier(const XcdBarrier& b) {
  asm volatile("s_waitcnt vmcnt(0)" ::: "memory");
  __syncthreads();
  if (threadIdx.x == 0) {
    unsigned* bar = b.bar;
    __builtin_amdgcn_s_waitcnt(0);
    unsigned nloc = b.st[0], nx = b.st[1];
    if (nloc == 0u) { xcd_barrier_complete(bar, b.x, nloc, nx); b.st[0] = nloc; b.st[1] = nx; }
    const unsigned old = xb_add(&bar[XB_XSUB(b.x)], 1u);
    const unsigned gen = old / nloc;
    if (old + 1u == (gen + 1u) * nloc) {
      __builtin_amdgcn_fence(__ATOMIC_RELEASE, "agent");
      asm volatile("s_waitcnt vmcnt(0)" ::: "memory");
      const unsigned og = xb_add(&bar[XB_TOP], 1u);
      const unsigned tg = og / nx;
      if (og + 1u == (tg + 1u) * nx) xb_add(&bar[XB_TOPGEN], 1u);
      else XB_SPIN(xb_ld(&bar[XB_TOPGEN]) == tg, bar);
      __builtin_amdgcn_fence(__ATOMIC_ACQUIRE, "agent");
      xb_add(&bar[XB_XGEN(b.x)], 1u);
      asm volatile("s_waitcnt vmcnt(0)" ::: "memory");
    } else {
      XB_SPIN(xb_ld(&bar[XB_XGEN(b.x)]) == gen, bar);
      __builtin_amdgcn_fence(__ATOMIC_ACQUIRE, "agent");
      asm volatile("s_waitcnt vmcnt(0)" ::: "memory");
    }
  }
  __syncthreads();
}

__device__ void transpose_item(const float* __restrict__ src, bf16_t* __restrict__ dst, const float* __restrict__ g,
                               int K, int N, int tk, int tn, float* Tf) {
  bf16_t* T = (bf16_t*)Tf;
  const int tid = otid();
  const int k0 = tk * 128, n0 = tn * 128;
  const int kr4 = (tid >> 5) * 4, nc = (tid & 31) * 4;
  __syncthreads();
#pragma unroll
  for (int hh = 0; hh < 2; ++hh) {
    f32x4 v[2][4];
#pragma unroll
    for (int h = 0; h < 2; ++h)
#pragma unroll
      for (int i = 0; i < 4; ++i) {
        const int kr = k0 + kr4 + 32 * (2 * hh + h) + i;
        v[h][i] = __builtin_nontemporal_load((const f32x4*)(src + (size_t)kr * N + n0 + nc));
        const float sc = g ? g[kr] : 1.f;
        v[h][i] *= sc;
      }
#pragma unroll
    for (int h = 0; h < 2; ++h)
#pragma unroll
      for (int j = 0; j < 4; ++j) {
        uint2 o; o.x = pk2(v[h][0][j], v[h][1][j]); o.y = pk2(v[h][2][j], v[h][3][j]);
        *(uint2*)(T + (nc + j) * 136 + kr4 + 32 * (2 * hh + h)) = o;
      }
  }
  __syncthreads();
#pragma unroll
  for (int j = 0; j < 8; ++j) {
    const int id = tid + 256 * j, n = id >> 4, c = id & 15;
    *(bf16x8*)(dst + (size_t)(n0 + n) * K + k0 + c * 8) = *(const bf16x8*)(T + n * 136 + c * 8);
  }
}

__device__ void phase_prologue(const Params& p, char* smem) {
  float* T = (float*)smem;
  const int G = gridDim.x, bid = blockIdx.x, tid = otid();
  constexpr int I_IN = DEPTH * 8 * 24, I_OUT = DEPTH * 8 * 8, I_UP = DEPTH * 8 * 32, I_DN = DEPTH * 32 * 8;
  constexpr int I_TOT = I_IN + I_OUT + I_UP + I_DN;
  for (int it = bid; it < I_TOT; it += G) {
    int i = it;
    if (i < I_IN) {
      int l = i / (8 * 24), r = i % (8 * 24);
      transpose_item(p.w_in + (size_t)l * D * INC, p.Wt_in + (size_t)l * D * INC, p.ln_mix + l * D, D, INC, r / 24, r % 24, T);
    } else if ((i -= I_IN) < I_OUT) {
      int l = i / 64, r = i % 64;
      transpose_item(p.w_out + (size_t)l * D * D, p.Wt_out + (size_t)l * D * D, nullptr, D, D, r / 8, r % 8, T);
    } else if ((i -= I_OUT) < I_UP) {
      int l = i / 256, r = i % 256;
      transpose_item(p.w_up + (size_t)l * D * DFF, p.Wt_up + (size_t)l * D * DFF, p.ln_mlp + l * D, D, DFF, r / 32, r % 32, T);
    } else {
      i -= I_UP;
      int l = i / 256, r = i % 256;
      transpose_item(p.w_down + (size_t)l * D * DFF, p.Wt_down + (size_t)l * D * DFF, nullptr, DFF, D, r / 8, r % 8, T);
    }
  }
  const int lane = tid & 63, wid = __builtin_amdgcn_readfirstlane(tid >> 6);
  for (int rg = bid; rg < MT / 4; rg += G) {
    int row = rg * 4 + wid;
    const float* src;
    if (row < MP) {
      int b = row / TP, t = row % TP;
      src = (t < NMETA) ? (p.meta + (size_t)t * D) : (p.x_prompt + ((size_t)b * SEQ + (t - NMETA)) * D);
    } else src = p.x_sample + (size_t)(row - MP) * D;
    float ss = 0.f;
#pragma unroll
    for (int i = 0; i < 2; ++i) {
      const int c = (i * 64 + lane) * 8;
      const f32x4 v0 = *(const f32x4*)(src + c), v1 = *(const f32x4*)(src + c + 4);
      const u32x4 o = {pk2(v0[0], v0[1]), pk2(v0[2], v0[3]), pk2(v1[0], v1[1]), pk2(v1[2], v1[3])};
      *(bf16x8*)(p.Xb + (size_t)row * D + c) = __builtin_bit_cast(bf16x8, o);
#pragma unroll
      for (int e = 0; e < 4; ++e) ss += v0[e] * v0[e] + v1[e] * v1[e];
    }
#pragma unroll
    for (int o = 32; o > 0; o >>= 1) ss += __shfl_xor(ss, o);
    if (lane < 16) p.SS[(size_t)row * 16 + lane] = (lane == 0) ? ss : 0.f;
  }
  for (int i = bid * 256 + tid; i < 512; i += G * 256) {
    float v0 = p.hgrn_lb[i], v1 = p.hgrn_lb[512 + i], v2 = p.hgrn_lb[1024 + i], v3 = p.hgrn_lb[1536 + i];
    float m = fmaxf(fmaxf(v0, v1), fmaxf(v2, v3));
    float e0 = expf(v0 - m), e1 = expf(v1 - m), e2 = expf(v2 - m), e3 = expf(v3 - m);
    float inv = 1.f / (e0 + e1 + e2 + e3);
    float s1 = e1 * inv, s2 = e2 * inv, s3 = e3 * inv;
    p.lb_all[i] = 0.f;
#pragma unroll
    for (int l = 0; l < DEPTH; ++l) p.lb_all[2048 + l * 512 + i] = log1pf(expf(-p.lam[l * 512 + i]));
    p.lb_all[512 + i] = fminf(fmaxf(s1, 0.f), 1.f);
    p.lb_all[1024 + i] = fminf(fmaxf(s1 + s2, 0.f), 1.f);
    p.lb_all[1536 + i] = fminf(fmaxf(s1 + s2 + s3, 0.f), 1.f);
  }
  for (int i = bid * 256 + tid; i < DEPTH * 8 * 128 * 64; i += G * 256) {
    int ii = i & 63, j = (i >> 6) & 127, lh = i >> 13;
    float v = (j < 64) ? p.w_ra[(size_t)lh * 4096 + ii * 64 + j] : p.w_rx[(size_t)lh * 4096 + ii * 64 + (j - 64)];
    p.Wg[i] = f2bf(v);
  }
}

enum { EPI_U = 0, EPI_UP = 1, EPI_RES = 2 };

template <int EPI, int RS>
__device__ void gemm_phase(const Params& p, const bf16_t* __restrict__ A, const bf16_t* __restrict__ Bt, int K, int N, bf16_t* Obf, char* smem_) {
  const int ntn = N >> 7, ntiles = (MT >> 7) * ntn;
  const int tid = otid(), lane = tid & 63, wid = __builtin_amdgcn_readfirstlane(tid >> 6), wr = wid >> 1, wc = wid & 1, fr = lane & 15, fq = lane >> 4;
  bf16_t* As = (bf16_t*)smem_;
  bf16_t* Bs = As + 2 * 128 * 64;
  const int lrow = tid >> 3;
  const int cg = ((tid & 7) ^ ((lrow >> 1) & 7)) * 8;
  const int sw0 = (fq ^ (fr >> 1)) * 8;
  const size_t rstep = (size_t)32 * K;
  const int nk = K >> 6;
  constexpr int CS = 8 / RS;
  const int xcd = blockIdx.x & 7, slots = gridDim.x >> 3, ncx = ntn / CS;
#define G_TM(J) (RS * ((J) / ncx) + (xcd % RS))
#define G_TN(J) (CS * ((J) % ncx) + (xcd / RS))
  int tile = blockIdx.x >> 3;
  if (G_TM(tile) >= (MT >> 7)) return;
  const bf16_t* ga = A + (size_t)(G_TM(tile) * 128 + lrow) * K + cg;
  const int lrowp = 8 * ((lrow & 15) >> 2) + 4 * (lrow >> 4) + (lrow & 3);
  const bf16_t* gb = Bt + (size_t)(G_TN(tile) * 128 + lrowp) * K + cg;
#define G_DMA(BUF, KT) { const int ko_ = (KT) * 64; _Pragma("unroll") for (int i = 0; i < 4; ++i) { \
    __builtin_amdgcn_global_load_lds((const unsigned*)(ga + i * rstep + ko_), (LAS unsigned*)(As + (BUF) * 8192 + i * 2048 + tid * 8), 16, 0, 0); \
    __builtin_amdgcn_global_load_lds((const unsigned*)(gb + i * rstep + ko_), (LAS unsigned*)(Bs + (BUF) * 8192 + i * 2048 + tid * 8), 16, 0, 0); } }
#define G_SB __builtin_amdgcn_sched_barrier(0)
#define G_A(MI, SO) (*(const bf16x8*)(as + (MI) * 16 * 64 + (SO)))
#define G_B(NI, SO) (*(const bf16x8*)(bs + (NI) * 16 * 64 + (SO)))
#define G_ROW(BF, MI) { _Pragma("unroll") for (int ni = 0; ni < 4; ++ni) acc[MI][ni] = mfma16(BF[ni], af[MI], acc[MI][ni]); }
#define G_COMPUTE(BUF) { const bf16_t* as = As + (BUF) * 128 * 64 + (wr * 64 + fr) * 64; const bf16_t* bs = Bs + (BUF) * 128 * 64 + (wc * 64 + fr) * 64; \
    const int so0 = sw0, so1 = sw0 ^ 32; bf16x8 af[4], b0[4], b1[4]; \
    _Pragma("unroll") for (int mi = 0; mi < 4; ++mi) af[mi] = G_A(mi, so0); \
    _Pragma("unroll") for (int ni = 0; ni < 4; ++ni) b0[ni] = G_B(ni, so0); \
    G_SB; __builtin_amdgcn_s_setprio(1); \
    G_ROW(b0, 0); G_SB; b1[0] = G_B(0, so1); b1[1] = G_B(1, so1); af[0] = G_A(0, so1); G_SB; \
    G_ROW(b0, 1); G_SB; b1[2] = G_B(2, so1); b1[3] = G_B(3, so1); af[1] = G_A(1, so1); G_SB; \
    G_ROW(b0, 2); G_SB; af[2] = G_A(2, so1); G_SB; \
    G_ROW(b0, 3); G_SB; af[3] = G_A(3, so1); G_SB; \
    G_ROW(b1, 0); G_ROW(b1, 1); G_ROW(b1, 2); G_ROW(b1, 3); \
    __builtin_amdgcn_s_setprio(0); }
  G_DMA(0, 0);
  __syncthreads();
  for (;;) {
    const int tm = G_TM(tile), tn = G_TN(tile);
    const int m0 = tm * 128, n0 = tn * 128;
    f32x4 acc[4][4];
#pragma unroll
    for (int mi = 0; mi < 4; ++mi)
#pragma unroll
      for (int ni = 0; ni < 4; ++ni) acc[mi][ni] = (f32x4){0.f, 0.f, 0.f, 0.f};
    for (int kt = 0; kt + 2 < nk; kt += 2) {
      G_DMA(1, kt + 1);
      G_SB;
      G_COMPUTE(0);
      __syncthreads();
      G_DMA(0, kt + 2);
      G_SB;
      G_COMPUTE(1);
      __syncthreads();
    }
    const int next = tile + slots;
    const bool more = G_TM(next) < (MT >> 7);
    const int nx = more ? next : tile;
    G_DMA(1, nk - 1);
    G_SB;
    G_COMPUTE(0);
    __syncthreads();
    ga = A + (size_t)(G_TM(nx) * 128 + lrow) * K + cg;
    gb = Bt + (size_t)(G_TN(nx) * 128 + lrowp) * K + cg;
    G_DMA(0, 0);
    G_SB;
    G_COMPUTE(1);
    __syncthreads();
#pragma unroll
    for (int mi = 0; mi < 4; ++mi) {
      const int row = m0 + wr * 64 + mi * 16 + fr;
      const int colb = n0 + wc * 64 + fq * 8;
      if (EPI == EPI_U || EPI == EPI_UP) {
        const f32x4 st = *((const f32x4*)(p.SS + (size_t)row * 16) + fq);
        float ss = (st[0] + st[1]) + (st[2] + st[3]);
        ss += __shfl_xor(ss, 16);
        ss += __shfl_xor(ss, 32);
        float sc = rsqrtf(ss * (1.f / D) + EPSN);
#pragma unroll
        for (int g = 0; g < 2; ++g) {
          f32x4 v0 = acc[mi][2 * g] * sc, v1 = acc[mi][2 * g + 1] * sc;
          if (EPI == EPI_UP) {
#pragma unroll
            for (int j = 0; j < 4; ++j) { float r0 = fmaxf(v0[j], 0.f), r1 = fmaxf(v1[j], 0.f); v0[j] = r0 * r0; v1[j] = r1 * r1; }
          }
          const u32x4 o = {pk2(v0[0], v0[1]), pk2(v0[2], v0[3]), pk2(v1[0], v1[1]), pk2(v1[2], v1[3])};
          *(bf16x8*)(Obf + (size_t)row * N + colb + g * 32) = __builtin_bit_cast(bf16x8, o);
        }
      } else {
        float part = 0.f;
#pragma unroll
        for (int g = 0; g < 2; ++g) {
          bf16_t* xp = p.Xb + (size_t)row * D + colb + g * 32;
          const bf16x8 xw = *(const bf16x8*)xp;
          f32x4 x0 = acc[mi][2 * g], x1 = acc[mi][2 * g + 1];
#pragma unroll
          for (int j = 0; j < 4; ++j) { x0[j] += bf2f((bf16_t)xw[j]); x1[j] += bf2f((bf16_t)xw[4 + j]); }
          const u32x4 o = {pk2(x0[0], x0[1]), pk2(x0[2], x0[3]), pk2(x1[0], x1[1]), pk2(x1[2], x1[3])};
          *(bf16x8*)xp = __builtin_bit_cast(bf16x8, o);
#pragma unroll
          for (int j = 0; j < 4; ++j) part += x0[j] * x0[j] + x1[j] * x1[j];
        }
        part += __shfl_xor(part, 16);
        part += __shfl_xor(part, 32);
        if (fq == 0) p.SS[(size_t)row * 16 + tn * 2 + wc] = part;
      }
    }
    if (!more) break;
    tile = next;
  }
#undef G_TM
#undef G_TN
#undef G_DMA
#undef G_COMPUTE
#undef G_SB
#undef G_A
#undef G_B
#undef G_ROW
}

template <bool SAMPLE>
__device__ void rg_item(const Params& p, int l, int item, char* smem) {
  float* XC = (float*)smem;
  float* AA = XC + 64 * 68;
  bf16_t* XA = (bf16_t*)(AA + 64 * 68);
  float* AG = (float*)(XA + 64 * LDT);
  const int tid = otid(), lane = tid & 63, wid = __builtin_amdgcn_readfirstlane(tid >> 6), fr = lane & 15, fq = lane >> 4;
  int hd, b = 0, c = 0, rb = 0, t0 = 0;
  if (SAMPLE) { hd = item & 7; rb = item >> 3; }
  else { hd = item & 7; int r = item >> 3; c = r % NCH; b = r / NCH; t0 = 64 * c - 48; }
  const bf16_t* U = p.UH;
  bf16x8 wfr[2][8];
  {
    const bf16_t* wg = p.Wg + (size_t)(l * 8 + hd) * 128 * 64;
#pragma unroll
    for (int kk = 0; kk < 2; ++kk)
#pragma unroll
      for (int ib = 0; ib < 8; ++ib) wfr[kk][ib] = *(const bf16x8*)(wg + (ib * 16 + fr) * 64 + kk * 32 + fq * 8);
  }
  f32x4 pbra[4], pbrx[4], plm[4];
#pragma unroll
  for (int ib = 0; ib < 4; ++ib) {
    const int chp = hd * 64 + ib * 16 + fq * 4;
    pbra[ib] = *(const f32x4*)(p.b_ra + l * 512 + chp);
    pbrx[ib] = *(const f32x4*)(p.b_rx + l * 512 + chp);
    plm[ib] = *(const f32x4*)(p.lb_all + 2048 + l * 512 + chp);
  }
  bf16_t* RAW = (bf16_t*)AA;
  bf16x8 rraw[3];
  if (!SAMPLE) {
#pragma unroll
    for (int i = 0; i < 3; ++i) {
      const int id = tid + 256 * i, rr = id >> 3, t = t0 - 3 + rr;
      const bf16x8 z = {0, 0, 0, 0, 0, 0, 0, 0};
      rraw[i] = (id < 67 * 8 && t >= 0) ? *(const bf16x8*)(U + ((size_t)b * TP + (t >= 0 ? t : 0)) * INC + hd * 64 + (id & 7) * 8) : z;
    }
  }
  float* RAWF = (float*)(smem + 47104);
  bf16_t* RAWU = (bf16_t*)(smem + 59392);
  bf16_t* RAWG = (bf16_t*)(smem + 67584);
  f32x4 rsf[3]; bf16x8 rsu[2], rsg[2];
  if (SAMPLE) {
#pragma unroll
    for (int i = 0; i < 3; ++i) {
      const int id = tid + 256 * i, r = id >> 4, c4 = (id & 15) * 4;
      rsf[i] = *(const f32x4*)(p.st_conv + ((size_t)(l * 128 + rb * 16) * 3 + r) * 512 + hd * 64 + c4);
    }
#pragma unroll
    for (int i = 0; i < 2; ++i) {
      const int id = tid + 256 * i, r = id >> 3, c8 = (id & 7) * 8;
      const bf16_t* ur = U + ((size_t)MP + rb * 64 + r) * INC + hd * 64 + c8;
      rsu[i] = *(const bf16x8*)ur;
      rsg[i] = *(const bf16x8*)(ur + 512);
    }
  }
  __syncthreads();
  if (!SAMPLE) {
#pragma unroll
    for (int i = 0; i < 3; ++i) {
      const int id = tid + 256 * i;
      if (id < 67 * 8) *(bf16x8*)(RAW + (id >> 3) * 72 + (id & 7) * 8) = rraw[i];
    }
    __syncthreads();
  } else {
#pragma unroll
    for (int i = 0; i < 3; ++i) { const int id = tid + 256 * i; *(f32x4*)(RAWF + (id >> 4) * 64 + (id & 15) * 4) = rsf[i]; }
#pragma unroll
    for (int i = 0; i < 2; ++i) { const int id = tid + 256 * i; *(bf16x8*)(RAWU + (id >> 3) * 64 + (id & 7) * 8) = rsu[i]; *(bf16x8*)(RAWG + (id >> 3) * 64 + (id & 7) * 8) = rsg[i]; }
    __syncthreads();
  }
  {
    const int i = tid & 63, tq = tid >> 6, ch = hd * 64 + i;
    const float cw0 = p.conv_w[(l * 4 + 0) * 512 + ch], cw1 = p.conv_w[(l * 4 + 1) * 512 + ch],
                cw2 = p.conv_w[(l * 4 + 2) * 512 + ch], cw3 = p.conv_w[(l * 4 + 3) * 512 + ch], cb = p.conv_b[l * 512 + ch];
    if (!SAMPLE) {
      const bf16_t* R = RAW + (tq * 16) * 72 + i;
      float x0 = bf2f(R[0]), x1 = bf2f(R[72]), x2 = bf2f(R[144]);
#pragma unroll
      for (int j = 0; j < 16; ++j) {
        float x3 = bf2f(R[(j + 3) * 72]);
        float xc = cb + cw0 * x0 + cw1 * x1 + cw2 * x2 + cw3 * x3;
        XC[(tq * 16 + j) * 68 + i] = xc;
        XA[(tq * 16 + j) * LDT + i] = f2bf(xc);
        x0 = x1; x1 = x2; x2 = x3;
      }
    } else {
#pragma unroll
      for (int bi = 0; bi < 4; ++bi) {
        const int sq = tq * 4 + bi;
        float x0 = RAWF[(sq * 3 + 0) * 64 + i], x1 = RAWF[(sq * 3 + 1) * 64 + i], x2 = RAWF[(sq * 3 + 2) * 64 + i];
#pragma unroll
        for (int t = 0; t < 4; ++t) {
          float x3 = bf2f(RAWU[(sq * 4 + t) * 64 + i]);
          float xc = cb + cw0 * x0 + cw1 * x1 + cw2 * x2 + cw3 * x3;
          int tt = tq * 16 + bi * 4 + t;
          XC[tt * 68 + i] = xc;
          XA[tt * LDT + i] = f2bf(xc);
          x0 = x1; x1 = x2; x2 = x3;
        }
      }
    }
  }
  __syncthreads();
  {
    f32x4 acc[8];
#pragma unroll
    for (int ib = 0; ib < 8; ++ib) acc[ib] = (f32x4){0.f, 0.f, 0.f, 0.f};
#pragma unroll
    for (int kk = 0; kk < 2; ++kk) {
      bf16x8 xb = *(const bf16x8*)(XA + (wid * 16 + fr) * LDT + kk * 32 + fq * 8);
#pragma unroll
      for (int ib = 0; ib < 8; ++ib) acc[ib] = mfma16(wfr[kk][ib], xb, acc[ib]);
    }
    const int tt = wid * 16 + fr;
    bool valid = SAMPLE ? true : (t0 + tt >= 0);
#pragma unroll
    for (int ib = 0; ib < 4; ++ib) {
      const int cl = ib * 16 + fq * 4, ch = hd * 64 + cl;
      const f32x4 bra = pbra[ib], brx = pbrx[ib], lm = plm[ib];
      f32x4 xc = *(const f32x4*)(XC + tt * 68 + cl);
      f32x4 av, bv;
#pragma unroll
      for (int j = 0; j < 4; ++j) {
        float rg = sigm(acc[ib][j] + bra[j]);
        float ig = sigm(acc[ib + 4][j] + brx[j]);
        float la = -8.f * rg * lm[j];
        float a = __expf(la);
        float t2 = 2.f * la;
        float om = (t2 > -0.1f) ? -t2 * (1.f + t2 * (0.5f + t2 * (0.16666667f + t2 * 0.041666668f))) : 1.f - __expf(t2);
        float bt = __builtin_amdgcn_sqrtf(fmaxf(om, 0.f)) * ig * xc[j];
        av[j] = valid ? a : 1.f;
        bv[j] = valid ? bt : 0.f;
      }
      *(f32x4*)(AA + tt * 68 + cl) = av;
      *(f32x4*)(XC + tt * 68 + cl) = bv;
    }
  }
  __syncthreads();
  const int cc = tid & 63, q = tid >> 6, ch = hd * 64 + cc;
  if (!SAMPLE) {
    float P = 1.f, h = 0.f;
#pragma unroll
    for (int j = 0; j < 16; ++j) {
      int tt = q * 16 + j;
      float a = AA[tt * 68 + cc], bt = XC[tt * 68 + cc];
      h = a * h + bt; P *= a;
      AA[tt * 68 + cc] = P; XC[tt * 68 + cc] = h;
    }
    AG[(q * 64 + cc) * 2] = P; AG[(q * 64 + cc) * 2 + 1] = h;
    __syncthreads();
    float Pin = 1.f, hin = 0.f;
    for (int qq = 0; qq < q; ++qq) {
      float Pq = AG[(qq * 64 + cc) * 2], hq = AG[(qq * 64 + cc) * 2 + 1];
      hin = Pq * hin + hq; Pin *= Pq;
    }
#pragma unroll
    for (int j = 0; j < 16; ++j) {
      const int tt = q * 16 + j;
      const float Pl = AA[tt * 68 + cc], hl = XC[tt * 68 + cc];
      AA[tt * 68 + cc] = Pl * Pin;
      XC[tt * 68 + cc] = hl + Pl * hin;
    }
    __syncthreads();
#pragma unroll
    for (int j = 0; j < 2; ++j) {
      const int id = tid + 256 * j, tt = id >> 3, c8 = (id & 7) * 8, t = t0 + tt;
      if (t >= 0) {
        const f32x4 pa = *(const f32x4*)(AA + tt * 68 + c8), pb = *(const f32x4*)(AA + tt * 68 + c8 + 4);
        const f32x4 ha = *(const f32x4*)(XC + tt * 68 + c8), hb = *(const f32x4*)(XC + tt * 68 + c8 + 4);
        const size_t o = ((size_t)b * TP + t) * 512 + hd * 64 + c8;
        const u32x4 po = {pk2(pa[0], pa[1]), pk2(pa[2], pa[3]), pk2(pb[0], pb[1]), pk2(pb[2], pb[3])};
        const u32x4 ho = {pk2(ha[0], ha[1]), pk2(ha[2], ha[3]), pk2(hb[0], hb[1]), pk2(hb[2], hb[3])};
        *(bf16x8*)(p.Pc + o) = __builtin_bit_cast(bf16x8, po);
        *(bf16x8*)(p.Hl + o) = __builtin_bit_cast(bf16x8, ho);
      }
    }
  } else {
#pragma unroll
    for (int bi = 0; bi < 4; ++bi) {
      const int bs = rb * 16 + q * 4 + bi;
      float h = p.st_h[(size_t)(l * 128 + bs) * 512 + ch];
#pragma unroll
      for (int t = 0; t < 4; ++t) {
        const int tt = q * 16 + bi * 4 + t;
        h = AA[tt * 68 + cc] * h + XC[tt * 68 + cc];
        XC[tt * 68 + cc] = h;
      }
    }
    __syncthreads();
#pragma unroll
    for (int j = 0; j < 2; ++j) {
      const int id = tid + 256 * j, tt = id >> 3, c8 = (id & 7) * 8, t = tt & 3, bs = rb * 16 + (tt >> 2);
      const f32x4 ha = *(const f32x4*)(XC + tt * 68 + c8), hb = *(const f32x4*)(XC + tt * 68 + c8 + 4);
      const bf16x8 gv = *(const bf16x8*)(RAWG + tt * 64 + c8), uv = *(const bf16x8*)(RAWU + tt * 64 + c8);
      float y[8];
#pragma unroll
      for (int e = 0; e < 4; ++e) { y[e] = ha[e] * gelu_t(bf2f((bf16_t)gv[e])); y[4 + e] = hb[e] * gelu_t(bf2f((bf16_t)gv[4 + e])); }
      const u32x4 yo = {pk2(y[0], y[1]), pk2(y[2], y[3]), pk2(y[4], y[5]), pk2(y[6], y[7])};
      *(bf16x8*)(p.Y + ((size_t)MP + rb * 64 + tt) * D + hd * 64 + c8) = __builtin_bit_cast(bf16x8, yo);
      if (t >= 1) {
        float* o = p.out + O_CS + ((size_t)(l * 128 + bs) * 3 + (t - 1)) * 512 + hd * 64 + c8;
        const f32x4 u0 = {bf2f((bf16_t)uv[0]), bf2f((bf16_t)uv[1]), bf2f((bf16_t)uv[2]), bf2f((bf16_t)uv[3])};
        const f32x4 u1 = {bf2f((bf16_t)uv[4]), bf2f((bf16_t)uv[5]), bf2f((bf16_t)uv[6]), bf2f((bf16_t)uv[7])};
        *(f32x4*)o = u0; *(f32x4*)(o + 4) = u1;
      }
      if (t == 3) {
        float* o = p.out + O_HS + (size_t)(l * 128 + bs) * 512 + hd * 64 + c8;
        *(f32x4*)o = ha; *(f32x4*)(o + 4) = hb;
      }
    }
  }
}

__device__ __forceinline__ void hgrn_fk(const bf16_t* __restrict__ Ub, int t0h, float lbv, float (&cs)[32], float (&kv)[32], float& run) {
  run = 0.f;
#pragma unroll
  for (int i = 0; i < 32; ++i) {
    int t = t0h + i;
    bool valid = t >= 0;
    float fpre = valid ? bf2f(Ub[(size_t)(valid ? t : 0) * INC]) : 0.f;
    float e = __expf(fminf(-fpre, 80.f));
    float sg = frcp(1.f + e);
    float f = lbv + (1.f - lbv) * sg;
    float lf = valid ? __logf(fmaxf(f, 1e-30f)) : 0.f;
    float kk = valid ? (1.f - lbv) * (e * sg) : 0.f;
    run += lf; cs[i] = run; kv[i] = kk;
  }
}

__device__ __forceinline__ void hgrn_load_vt(const bf16_t* __restrict__ Uv, int t0h, bf16_t* Vt, int v, int half) {
#pragma unroll
  for (int g = 0; g < 4; ++g) {
    unsigned w[4];
#pragma unroll
    for (int e = 0; e < 4; ++e) {
      int ta = t0h + g * 8 + e * 2, tb = ta + 1;
      unsigned lo = (ta >= 0) ? (unsigned)Uv[(size_t)(ta >= 0 ? ta : 0) * INC] : 0u;
      unsigned hi = (tb >= 0) ? (unsigned)Uv[(size_t)(tb >= 0 ? tb : 0) * INC] : 0u;
      w[e] = lo | (hi << 16);
    }
    uint4 o; o.x = w[0]; o.y = w[1]; o.z = w[2]; o.w = w[3];
    *(uint4*)(Vt + v * LDT + half * 32 + g * 8) = o;
  }
}

__device__ __forceinline__ void load_tile_regs(const bf16_t* __restrict__ Ucol, int t0, int tid, bf16x8 (&r)[4]) {
#pragma unroll
  for (int i = 0; i < 4; ++i) {
    const int id = tid + 256 * i, row = id >> 4, ch = (id & 15) * 8, t = t0 + row;
    const bf16x8 z = {0, 0, 0, 0, 0, 0, 0, 0};
    r[i] = (t >= 0) ? *(const bf16x8*)(Ucol + (size_t)(t >= 0 ? t : 0) * INC + ch) : z;
  }
}
__device__ __forceinline__ void store_tile_regs(bf16_t* L, int tid, const bf16x8 (&r)[4]) {
#pragma unroll
  for (int i = 0; i < 4; ++i) {
    const int id = tid + 256 * i, row = id >> 4, ch = (id & 15) * 8;
    *(bf16x8*)(L + row * LDQ + ch) = r[i];
  }
}
__device__ __forceinline__ void hgrn_fk_lds(const bf16_t* Fcol, int t0h, float lbv, float (&fv)[32], float (&kv)[32]) {
#pragma unroll
  for (int i = 0; i < 32; ++i) {
    const bool valid = (t0h + i) >= 0;
    float fpre = bf2f(Fcol[i * LDQ]);
    float e = __expf(fminf(-fpre, 80.f));
    float sg = frcp(1.f + e);
    float f = fmaxf(lbv + (1.f - lbv) * sg, 1e-30f);
    fv[i] = valid ? f : 1.f;
    kv[i] = valid ? (1.f - lbv) * (e * sg) : 0.f;
  }
}

__device__ void hgrn_local(const Params& p, int l, int item, char* smem) {
  bf16_t* Kt = (bf16_t*)smem;
  bf16_t* Fr = Kt;
  bf16_t* Vt = Kt + 128 * LDT;
  bf16_t* Vr = Vt;
  float* tots = (float*)(Vt + 128 * LDT);
  const int tid = otid(), lane = tid & 63, wid = __builtin_amdgcn_readfirstlane(tid >> 6), fr = lane & 15, fq = lane >> 4;
  const int c = item % NCH, bh = item / NCH, h = bh & 3, b = bh >> 2;
  const int t0 = 64 * c - 48;
  const int k = tid & 127, half = tid >> 7;
  const bf16_t* Ub = p.UH + (size_t)b * TP * INC;
  {
    bf16x8 rf[4], rv[4];
    load_tile_regs(Ub + 1536 + h * 128, t0, tid, rf);
    load_tile_regs(Ub + 2048 + h * 128, t0, tid, rv);
    __syncthreads();
    store_tile_regs(Fr, tid, rf);
    store_tile_regs(Vr, tid, rv);
  }
  const float lbv = p.lb_all[l * 512 + h * 128 + k];
  __syncthreads();
  float fv[32], kv[32];
  hgrn_fk_lds(Fr + (half * 32) * LDQ + k, t0 + half * 32, lbv, fv, kv);
  float run = 1.f;
#pragma unroll
  for (int i = 31; i >= 0; --i) { kv[i] *= run; run *= fv[i]; }
  tots[half * 128 + k] = run;
  unsigned vw[16];
#pragma unroll
  for (int e = 0; e < 16; ++e) {
    const int ta = half * 32 + e * 2;
    vw[e] = (unsigned)Vr[ta * LDQ + k] | ((unsigned)Vr[(ta + 1) * LDQ + k] << 16);
  }
  __syncthreads();
  const float after = (half == 0) ? tots[128 + k] : 1.f;
  if (half == 0) p.dec[((size_t)bh * NCH + c) * 128 + k] = run * after;
#pragma unroll
  for (int g = 0; g < 4; ++g) {
    float v[8];
#pragma unroll
    for (int e = 0; e < 8; ++e) v[e] = kv[g * 8 + e] * after;
    const u32x4 ko = {pk2(v[0], v[1]), pk2(v[2], v[3]), pk2(v[4], v[5]), pk2(v[6], v[7])};
    *(bf16x8*)(Kt + k * LDT + half * 32 + g * 8) = __builtin_bit_cast(bf16x8, ko);
    const u32x4 vo = {vw[g * 4 + 0], vw[g * 4 + 1], vw[g * 4 + 2], vw[g * 4 + 3]};
    *(bf16x8*)(Vt + k * LDT + half * 32 + g * 8) = __builtin_bit_cast(bf16x8, vo);
  }
  __syncthreads();
  f32x4 acc[8][2];
#pragma unroll
  for (int ib = 0; ib < 8; ++ib) { acc[ib][0] = (f32x4){0.f, 0.f, 0.f, 0.f}; acc[ib][1] = (f32x4){0.f, 0.f, 0.f, 0.f}; }
#pragma unroll
  for (int kk = 0; kk < 2; ++kk) {
    bf16x8 vb0 = *(const bf16x8*)(Vt + (wid * 32 + fr) * LDT + kk * 32 + fq * 8);
    bf16x8 vb1 = *(const bf16x8*)(Vt + (wid * 32 + 16 + fr) * LDT + kk * 32 + fq * 8);
#pragma unroll
    for (int ib = 0; ib < 8; ++ib) {
      bf16x8 ka = *(const bf16x8*)(Kt + (32 * (ib >> 1) + 8 * (fr >> 2) + 4 * (ib & 1) + (fr & 3)) * LDT + kk * 32 + fq * 8);
      acc[ib][0] = mfma16(ka, vb0, acc[ib][0]);
      acc[ib][1] = mfma16(ka, vb1, acc[ib][1]);
    }
  }
  bf16_t* Sb = p.Sbuf + ((size_t)bh * NCH + c) * 16384;
#pragma unroll
  for (int g = 0; g < 4; ++g)
#pragma unroll
    for (int jn = 0; jn < 2; ++jn) {
      const int v = wid * 32 + jn * 16 + fr, kb = 32 * g + 8 * fq;
      const f32x4 a0 = acc[2 * g][jn], a1 = acc[2 * g + 1][jn];
      const u32x4 o = {pk2(a0[0], a0[1]), pk2(a0[2], a0[3]), pk2(a1[0], a1[1]), pk2(a1[2], a1[3])};
      *(bf16x8*)(Sb + v * 128 + kb) = __builtin_bit_cast(bf16x8, o);
    }
}

__device__ void hgrn_out(const Params& p, int l, int item, char* smem) {
  bf16_t* Qs = (bf16_t*)smem;
  bf16_t* Ks = Qs + 64 * LDQ;
  bf16_t* Vt = Ks + 64 * LDQ;
  bf16_t* Am = Vt + 128 * LDT;
  bf16_t* Vr = Am;
  float* eref = (float*)(Vr + 64 * LDQ);
  const int tid = otid(), lane = tid & 63, wid = __builtin_amdgcn_readfirstlane(tid >> 6), fr = lane & 15, fq = lane >> 4;
  const int c = item % NCH, bh = item / NCH, h = bh & 3, b = bh >> 2;
  const int t0 = 64 * c - 48;
  const int k = tid & 127, half = tid >> 7;
  const bf16_t* Ub = p.UH + (size_t)b * TP * INC;
  const bf16_t* Sb = p.Sbuf + ((size_t)bh * NCH + c) * 16384;
  const int tw = wid * 16 + fr;
  {
    bf16x8 rq[4], rf[4], rv[4];
    load_tile_regs(Ub + 1024 + h * 128, t0, tid, rq);
    load_tile_regs(Ub + 1536 + h * 128, t0, tid, rf);
    load_tile_regs(Ub + 2048 + h * 128, t0, tid, rv);
    __syncthreads();
    store_tile_regs(Qs, tid, rq);
    store_tile_regs(Ks, tid, rf);
    store_tile_regs(Vr, tid, rv);
  }
  const float lbv = p.lb_all[l * 512 + h * 128 + k];
  __syncthreads();
  {
    float fv[32], kv[32];
    hgrn_fk_lds(Ks + (half * 32) * LDQ + k, t0 + half * 32, lbv, fv, kv);
    if (half == 0) {
      float R = 1.f;
#pragma unroll
      for (int i = 31; i >= 0; --i) { const float Rc = fmaxf(R, 1e-30f); const float kk = kv[i]; kv[i] = kk * Rc; R *= fv[i]; fv[i] = frcp(Rc); }
      eref[k] = R;
    } else {
      float F = 1.f;
#pragma unroll
      for (int i = 0; i < 32; ++i) { F *= fv[i]; const float Fc = fmaxf(F, 1e-30f); fv[i] = Fc; kv[i] *= frcp(Fc); }
    }
#pragma unroll
    for (int i = 0; i < 32; ++i) {
      const bool valid = (t0 + half * 32 + i) >= 0;
      float qb = bf2f(Qs[(half * 32 + i) * LDQ + k]);
      float qv = valid ? silu(qb) * 0.08838834764831845f : 0.f;
      Qs[(half * 32 + i) * LDQ + k] = f2bf(qv * fv[i]);
      Ks[(half * 32 + i) * LDQ + k] = f2bf(kv[i]);
    }
#pragma unroll
    for (int g = 0; g < 4; ++g) {
      unsigned w[4];
#pragma unroll
      for (int e = 0; e < 4; ++e) {
        const int ta = half * 32 + g * 8 + e * 2;
        w[e] = (unsigned)Vr[ta * LDQ + k] | ((unsigned)Vr[(ta + 1) * LDQ + k] << 16);
      }
      const u32x4 o = {w[0], w[1], w[2], w[3]};
      *(bf16x8*)(Vt + k * LDT + half * 32 + g * 8) = __builtin_bit_cast(bf16x8, o);
    }
  }
#define VROW(IB) (32 * ((IB) >> 1) + 8 * (fr >> 2) + 4 * ((IB) & 1) + (fr & 3))
  bf16x8 sf0[8], sf1[8];
#pragma unroll
  for (int ib = 0; ib < 8; ++ib) {
    sf0[ib] = *(const bf16x8*)(Sb + VROW(ib) * 128 + fq * 8);
    sf1[ib] = *(const bf16x8*)(Sb + VROW(ib) * 128 + 32 + fq * 8);
  }
  __syncthreads();
  f32x4 acc[8];
#pragma unroll
  for (int ib = 0; ib < 8; ++ib) acc[ib] = (f32x4){0.f, 0.f, 0.f, 0.f};
  bf16x8 qf[4];
#pragma unroll
  for (int kk = 0; kk < 4; ++kk) qf[kk] = *(const bf16x8*)(Qs + tw * LDQ + kk * 32 + fq * 8);
  {
#pragma unroll
    for (int ib = 0; ib < 4; ++ib) {
      f32x4 a = (f32x4){0.f, 0.f, 0.f, 0.f};
      if (ib <= wid) {
#pragma unroll
        for (int kk = 0; kk < 4; ++kk) {
          bf16x8 kf = *(const bf16x8*)(Ks + (ib * 16 + fr) * LDQ + kk * 32 + fq * 8);
          a = mfma16(kf, qf[kk], a);
        }
      }
      const int sb = ib * 16 + fq * 4;
      float a0 = (sb + 0 <= tw) ? a[0] : 0.f, a1 = (sb + 1 <= tw) ? a[1] : 0.f, a2 = (sb + 2 <= tw) ? a[2] : 0.f, a3 = (sb + 3 <= tw) ? a[3] : 0.f;
      if (ib > wid) { a0 = 0.f; a1 = 0.f; a2 = 0.f; a3 = 0.f; }
      uint2 o; o.x = pk2(a0, a1); o.y = pk2(a2, a3);
      *(uint2*)(Am + tw * LDT + sb) = o;
    }
  }
#define QHAT(KK, QH) { const f32x4* er = (const f32x4*)(eref + (KK) * 32 + fq * 8); const f32x4 e0 = er[0], e1 = er[1]; float qv_[8]; \
    _Pragma("unroll") for (int e = 0; e < 8; ++e) qv_[e] = bf2f((bf16_t)qf[KK][e]) * (e < 4 ? e0[e & 3] : e1[e & 3]); \
    const u32x4 pq_ = {pk2(qv_[0], qv_[1]), pk2(qv_[2], qv_[3]), pk2(qv_[4], qv_[5]), pk2(qv_[6], qv_[7])}; QH = __builtin_bit_cast(bf16x8, pq_); }
  {
    bf16x8 qh;
    QHAT(0, qh);
#pragma unroll
    for (int ib = 0; ib < 8; ++ib) acc[ib] = mfma16(sf0[ib], qh, acc[ib]);
    QHAT(1, qh);
#pragma unroll
    for (int ib = 0; ib < 8; ++ib) acc[ib] = mfma16(sf1[ib], qh, acc[ib]);
  }
#pragma unroll
  for (int ib = 0; ib < 8; ++ib) {
    sf0[ib] = *(const bf16x8*)(Sb + VROW(ib) * 128 + 64 + fq * 8);
    sf1[ib] = *(const bf16x8*)(Sb + VROW(ib) * 128 + 96 + fq * 8);
  }
  const int tg = t0 + tw;
  const size_t row = (size_t)b * TP + (tg >= 0 ? tg : 0);
  bf16x8 gw[4];
#pragma unroll
  for (int g = 0; g < 4; ++g) gw[g] = *(const bf16x8*)(p.UH + row * INC + 2560 + h * 128 + 32 * g + 8 * fq);
  __syncthreads();
  {
#pragma unroll
    for (int kk = 0; kk < 2; ++kk) {
      bf16x8 af = *(const bf16x8*)(Am + tw * LDT + kk * 32 + fq * 8);
#pragma unroll
      for (int ib = 0; ib < 8; ++ib) {
        bf16x8 vf = *(const bf16x8*)(Vt + VROW(ib) * LDT + kk * 32 + fq * 8);
        acc[ib] = mfma16(vf, af, acc[ib]);
      }
    }
    bf16x8 qh;
    QHAT(2, qh);
#pragma unroll
    for (int ib = 0; ib < 8; ++ib) acc[ib] = mfma16(sf0[ib], qh, acc[ib]);
    QHAT(3, qh);
#pragma unroll
    for (int ib = 0; ib < 8; ++ib) acc[ib] = mfma16(sf1[ib], qh, acc[ib]);
    float ss = 0.f;
#pragma unroll
    for (int ib = 0; ib < 8; ++ib) ss += acc[ib][0] * acc[ib][0] + acc[ib][1] * acc[ib][1] + acc[ib][2] * acc[ib][2] + acc[ib][3] * acc[ib][3];
    ss += __shfl_xor(ss, 16);
    ss += __shfl_xor(ss, 32);
    const float sc = rsqrtf(ss * (1.f / 128.f) + EPSN);
    if (tg >= 0) {
#pragma unroll
      for (int g = 0; g < 4; ++g) {
        const int v = 32 * g + 8 * fq;
        const f32x4 gn0 = *(const f32x4*)(p.gn + l * 128 + v), gn1 = *(const f32x4*)(p.gn + l * 128 + v + 4);
        float y[8];
#pragma unroll
        for (int e = 0; e < 4; ++e) {
          y[e] = acc[2 * g][e] * sc * gn0[e] * silu(bf2f((bf16_t)gw[g][e]));
          y[4 + e] = acc[2 * g + 1][e] * sc * gn1[e] * silu(bf2f((bf16_t)gw[g][4 + e]));
        }
        const u32x4 o = {pk2(y[0], y[1]), pk2(y[2], y[3]), pk2(y[4], y[5]), pk2(y[6], y[7])};
        *(bf16x8*)(p.Y + row * D + 512 + h * 128 + v) = __builtin_bit_cast(bf16x8, o);
      }
    }
  }
#undef VROW
#undef QHAT
}

__device__ void hgrn_sample(const Params& p, int l, int item, char* smem) {
  float* qf = (float*)smem;
  float* ff = qf + 512;
  float* kf = ff + 512;
  float* PO = kf + 512;
  const int tid = otid(), lane = tid & 63, wid = __builtin_amdgcn_readfirstlane(tid >> 6);
  const int h = item & 3, bs = item >> 2;
  const int kq = tid >> 5, v4 = (tid & 31) * 4;
  const size_t sbase = ((size_t)(l * 128 + bs) * 4 + h) * 16384;
  const size_t row0 = (size_t)MP + bs * 4;
  __syncthreads();
  f32x4 S[16];
#pragma unroll
  for (int r = 0; r < 16; ++r) S[r] = __builtin_nontemporal_load((const f32x4*)(p.st_S + sbase + (size_t)(kq * 16 + r) * 128 + v4));
#pragma unroll
  for (int j = 0; j < 2; ++j) {
    int idx = tid + 256 * j, t = idx >> 7, k = idx & 127;
    const bf16_t* ur = p.UH + (row0 + t) * INC + h * 128 + k;
    float qb = bf2f(ur[1024]), fpre = bf2f(ur[1536]);
    float lbv = p.lb_all[l * 512 + h * 128 + k];
    float e = __expf(fminf(-fpre, 80.f));
    float sg = frcp(1.f + e);
    qf[idx] = silu(qb) * 0.08838834764831845f;
    ff[idx] = fmaxf(lbv + (1.f - lbv) * sg, 1e-30f);
    kf[idx] = (1.f - lbv) * (e * sg);
  }
  __syncthreads();
#pragma unroll
  for (int t = 0; t < 4; ++t) {
    uint2 vw = *(const uint2*)(p.UH + (row0 + t) * INC + 2048 + h * 128 + v4);
    f32x4 vt = (f32x4){__uint_as_float(vw.x << 16), __uint_as_float(vw.x & 0xffff0000u), __uint_as_float(vw.y << 16), __uint_as_float(vw.y & 0xffff0000u)};
    f32x4 po = (f32x4){0.f, 0.f, 0.f, 0.f};
#pragma unroll
    for (int r = 0; r < 16; ++r) {
      int k = kq * 16 + r;
      float f = ff[t * 128 + k], kk = kf[t * 128 + k], q = qf[t * 128 + k];
      S[r] = S[r] * f + vt * kk;
      po += S[r] * q;
    }
    *(f32x4*)(PO + (kq * 4 + t) * 128 + v4) = po;
  }
#pragma unroll
  for (int r = 0; r < 16; ++r) __builtin_nontemporal_store(S[r], (f32x4*)(p.out + O_SS + sbase + (size_t)(kq * 16 + r) * 128 + v4));
  __syncthreads();
  {
    const int t = wid;
    float o0 = 0.f, o1 = 0.f;
#pragma unroll
    for (int g = 0; g < 8; ++g) { o0 += PO[(g * 4 + t) * 128 + lane]; o1 += PO[(g * 4 + t) * 128 + 64 + lane]; }
    float ss = o0 * o0 + o1 * o1;
#pragma unroll
    for (int o = 32; o > 0; o >>= 1) ss += __shfl_xor(ss, o);
    const float sc = rsqrtf(ss * (1.f / 128.f) + EPSN);
    const size_t row = row0 + t;
    float g0 = bf2f(p.UH[row * INC + 2560 + h * 128 + lane]), g1 = bf2f(p.UH[row * INC + 2560 + h * 128 + 64 + lane]);
    p.Y[row * D + 512 + h * 128 + lane] = f2bf(o0 * sc * p.gn[l * 128 + lane] * silu(g0));
    p.Y[row * D + 512 + h * 128 + 64 + lane] = f2bf(o1 * sc * p.gn[l * 128 + 64 + lane] * silu(g1));
  }
}

__device__ void mixer_local(const Params& p, int l, char* smem) {
  constexpr int N_RGP = NB * NCH * 8, N_HL = 32 * NCH;
  constexpr int TOT = N_RGP + N_HL;
  for (int it = blockIdx.x; it < TOT; it += gridDim.x) {
    int i = it;
    if (i < N_HL) hgrn_local(p, l, i, smem);
    else rg_item<false>(p, l, i - N_HL, smem);
  }
}

__device__ void mixer_carry(const Params& p, int l, char* smem) {
  const int G = gridDim.x, bid = blockIdx.x, tid = otid();
  for (int it = bid; it < 256 + 16 + 512 + 64; it += G) {
    if (it >= 272 + 512) rg_item<true>(p, l, it - 272 - 512, smem);
    else if (it >= 272) hgrn_sample(p, l, it - 272, smem);
    else if (it < 256) {
      int gt = it * 256 + tid;
      int bh = gt >> 11, e = gt & 2047, v = e >> 4, k8 = (e & 15) * 8;
      float S[8];
#pragma unroll
      for (int j = 0; j < 8; ++j) S[j] = 0.f;
      bf16_t* sb = p.Sbuf + (size_t)bh * NCH * 16384 + v * 128 + k8;
      const float* dc = p.dec + (size_t)bh * NCH * 128 + k8;
      uint4 lwv[NCH];
#pragma unroll
      for (int c = 0; c < NCH; ++c) lwv[c] = *(const uint4*)(sb + (size_t)c * 16384);
#pragma unroll
      for (int c = 0; c < NCH; ++c) {
        const uint4 lw = lwv[c];
        f32x4 d0 = *(const f32x4*)(dc + c * 128), d1 = *(const f32x4*)(dc + c * 128 + 4);
        *(uint4*)(sb + (size_t)c * 16384) = pack8(S);
        S[0] = S[0] * d0[0] + __uint_as_float(lw.x << 16); S[1] = S[1] * d0[1] + __uint_as_float(lw.x & 0xffff0000u);
        S[2] = S[2] * d0[2] + __uint_as_float(lw.y << 16); S[3] = S[3] * d0[3] + __uint_as_float(lw.y & 0xffff0000u);
        S[4] = S[4] * d1[0] + __uint_as_float(lw.z << 16); S[5] = S[5] * d1[1] + __uint_as_float(lw.z & 0xffff0000u);
        S[6] = S[6] * d1[2] + __uint_as_float(lw.w << 16); S[7] = S[7] * d1[3] + __uint_as_float(lw.w & 0xffff0000u);
      }
      float* o = p.out + O_SP + ((size_t)(l * 32 + bh)) * 16384;
#pragma unroll
      for (int j = 0; j < 8; ++j) o[(size_t)(k8 + j) * 128 + v] = S[j];
    } else {
      int gt = (it - 256) * 256 + tid;
      int b = gt >> 9, ch = gt & 511;
      float carry = 0.f;
      float Pl[NCH], hl[NCH];
#pragma unroll
      for (int c = 0; c < NCH; ++c) {
        size_t row = (size_t)b * TP + 15 + 64 * c;
        Pl[c] = bf2f(p.Pc[row * 512 + ch]); hl[c] = bf2f(p.Hl[row * 512 + ch]);
      }
#pragma unroll
      for (int c = 0; c < NCH; ++c) {
        p.carry[((size_t)b * NCH + c) * 512 + ch] = carry;
        carry = Pl[c] * carry + hl[c];
      }
      p.out[O_HP + (size_t)(l * 8 + b) * 512 + ch] = carry;
#pragma unroll
      for (int j = 0; j < 3; ++j)
        p.out[O_CP + ((size_t)(l * 8 + b) * 3 + j) * 512 + ch] = bf2f(p.UH[((size_t)b * TP + TP - 3 + j) * INC + ch]);
    }
  }
}

__device__ void mixer_out(const Params& p, int l, char* smem) {
  constexpr int N_HO = 32 * NCH, N_RO = MP / 16;
  for (int it = blockIdx.x; it < N_HO + N_RO; it += gridDim.x) {
    if (it < N_HO) hgrn_out(p, l, it, smem);
    else {
      const int r0 = (it - N_HO) * 16;
      const int tid = otid();
#pragma unroll
      for (int j = 0; j < 4; ++j) {
        const int idx = tid + 256 * j;
        const int row = r0 + (idx >> 6), ch = (idx & 63) * 8;
        const int b = row / TP, t = row % TP, c = (t + 48) >> 6;
        const bf16x8 pw = *(const bf16x8*)(p.Pc + (size_t)row * 512 + ch), hw = *(const bf16x8*)(p.Hl + (size_t)row * 512 + ch);
        const bf16x8 gw = *(const bf16x8*)(p.UH + (size_t)row * INC + 512 + ch);
        const f32x4 c0 = *(const f32x4*)(p.carry + ((size_t)b * NCH + c) * 512 + ch), c1 = *(const f32x4*)(p.carry + ((size_t)b * NCH + c) * 512 + ch + 4);
        float y[8];
#pragma unroll
        for (int e = 0; e < 8; ++e) {
          const float hv = bf2f((bf16_t)hw[e]) + bf2f((bf16_t)pw[e]) * (e < 4 ? c0[e & 3] : c1[e & 3]);
          y[e] = hv * gelu_t(bf2f((bf16_t)gw[e]));
        }
        const u32x4 o = {pk2(y[0], y[1]), pk2(y[2], y[3]), pk2(y[4], y[5]), pk2(y[6], y[7])};
        *(bf16x8*)(p.Y + (size_t)row * D + ch) = __builtin_bit_cast(bf16x8, o);
      }
    }
  }
}

__device__ void phase_final(const Params& p) {
  const int tid = otid(), lane = tid & 63, wid = __builtin_amdgcn_readfirstlane(tid >> 6);
  for (int rg = blockIdx.x; rg < MT / 4; rg += gridDim.x) {
    int row = rg * 4 + wid;
    float* dst;
    if (row < MP) {
      int b = row / TP, t = row % TP;
      if (t < NMETA) continue;
      dst = p.out + O_YP + ((size_t)b * SEQ + (t - NMETA)) * D;
    } else dst = p.out + O_YS + (size_t)(row - MP) * D;
    float v[2][8];
    float ss = 0.f;
#pragma unroll
    for (int i = 0; i < 2; ++i) {
      const bf16x8 xw = *(const bf16x8*)(p.Xb + (size_t)row * D + (i * 64 + lane) * 8);
#pragma unroll
      for (int e = 0; e < 8; ++e) { v[i][e] = bf2f((bf16_t)xw[e]); ss += v[i][e] * v[i][e]; }
    }
#pragma unroll
    for (int o = 32; o > 0; o >>= 1) ss += __shfl_xor(ss, o);
    float sc = rsqrtf(ss * (1.f / D) + EPSN);
#pragma unroll
    for (int i = 0; i < 2; ++i) {
      const int c = (i * 64 + lane) * 8;
      const f32x4 g0 = *(const f32x4*)(p.ln_final + c), g1 = *(const f32x4*)(p.ln_final + c + 4);
      const f32x4 o0 = {v[i][0] * sc * g0[0], v[i][1] * sc * g0[1], v[i][2] * sc * g0[2], v[i][3] * sc * g0[3]};
      const f32x4 o1 = {v[i][4] * sc * g1[0], v[i][5] * sc * g1[1], v[i][6] * sc * g1[2], v[i][7] * sc * g1[3]};
      __builtin_nontemporal_store(o0, (f32x4*)(dst + c));
      __builtin_nontemporal_store(o1, (f32x4*)(dst + c + 4));
    }
  }
}

#ifndef SKIPI
#define SKIPI 0
#endif
#define RS_IN 2
#define RS_OUT 2
#define RS_UP 2
#define RS_DN 4
#ifndef PROBE_ML
#define PROBE_ML 1
#define PROBE_MO 1
#define PROBE_PR 1
#endif
#ifndef PROBE_REP
#define PROBE_REP 1
#endif
#ifndef MULTI_LAUNCH
#define MULTI_LAUNCH 0
#endif
constexpr int NPH = 2 + 7 * DEPTH;
__global__ void __launch_bounds__(256, 2) mega(Params p, int ph_lo, int ph_hi) {
  extern __shared__ __attribute__((aligned(16))) char smem[];
  volatile LAS unsigned* xbw = (volatile LAS unsigned*)(smem + SMEM_BYTES);
  if (threadIdx.x < 4) xbw[threadIdx.x] = 0u;
  __syncthreads();
  XcdBarrier xb = xcd_barrier_post(p.bar, xbw);
  for (int ph = ph_lo; ph < ph_hi; ++ph) {
    if (ph == 0) { for (int rep = 0; rep < PROBE_PR; ++rep) phase_prologue(p, smem); }
    else if (ph == NPH - 1) phase_final(p);
    else {
      const int l = (ph - 1) / 7, j = (ph - 1) % 7;
#ifdef SKIP_MASK
      if ((SKIP_MASK >> j) & 1) continue;
#endif
      switch (j) {
        case 0: for (int rep = 0; rep < PROBE_REP; ++rep) gemm_phase<EPI_U, RS_IN>(p, p.Xb, p.Wt_in + (size_t)l * D * INC, D, INC, p.UH, smem); break;
        case 1: for (int rep = 0; rep < PROBE_ML; ++rep) mixer_local(p, l, smem); break;
        case 2: mixer_carry(p, l, smem); break;
        case 3: for (int rep = 0; rep < PROBE_MO; ++rep) mixer_out(p, l, smem); break;
        case 4: gemm_phase<EPI_RES, RS_OUT>(p, p.Y, p.Wt_out + (size_t)l * D * D, D, D, nullptr, smem); break;
        case 5: for (int rep = 0; rep < PROBE_REP; ++rep) gemm_phase<EPI_UP, RS_UP>(p, p.Xb, p.Wt_up + (size_t)l * D * DFF, D, DFF, p.UH, smem); break;
        default: gemm_phase<EPI_RES, RS_DN>(p, p.UH, p.Wt_down + (size_t)l * D * DFF, DFF, D, nullptr, smem); break;
      }
    }
    if (ph + 1 < ph_hi) xcd_barrier(xb);
  }
}

extern "C" void kernel_launch(void* const* d_in, const int* in_sizes, int n_in, void* d_out, int out_size, void* d_ws, size_t ws_size,
                              hipStream_t stream) {
  static int grid_blocks = 0;
  if (!grid_blocks) {
    int dev = 0, cus = 0, per_cu = 0;
    hipGetDevice(&dev);
    hipDeviceGetAttribute(&cus, hipDeviceAttributeMultiprocessorCount, dev);
    hipFuncSetAttribute((const void*)mega, hipFuncAttributeMaxDynamicSharedMemorySize, SMEM_ALLOC);
    hipOccupancyMaxActiveBlocksPerMultiprocessor(&per_cu, mega, 256, SMEM_ALLOC);
    if (per_cu > 2) per_cu = 2;
    if (per_cu < 1) per_cu = 1;
    grid_blocks = (cus * per_cu) & ~7;
  }
  Params p{};
  const float* const* in = (const float* const*)d_in;
  p.x_prompt = in[0]; p.x_sample = in[1]; p.st_h = in[2]; p.st_conv = in[3]; p.st_S = in[4]; p.meta = in[5]; p.ln_mix = in[6];
  p.w_in = in[7]; p.conv_w = in[8]; p.conv_b = in[9]; p.w_ra = in[10]; p.b_ra = in[11]; p.w_rx = in[12]; p.b_rx = in[13];
  p.lam = in[14]; p.hgrn_lb = in[15]; p.gn = in[16]; p.w_out = in[17]; p.ln_mlp = in[18]; p.w_up = in[19]; p.w_down = in[20];
  p.ln_final = in[21];
  p.out = (float*)d_out;
  char* w = (char*)d_ws;
  size_t off = 0;
  auto take = [&](size_t bytes) { char* r = w + off; off += (bytes + 255) & ~(size_t)255; return r; };
  p.Wt_in = (bf16_t*)take((size_t)DEPTH * D * INC * 2);
  p.Wt_out = (bf16_t*)take((size_t)DEPTH * D * D * 2);
  p.Wt_up = (bf16_t*)take((size_t)DEPTH * D * DFF * 2);
  p.Wt_down = (bf16_t*)take((size_t)DEPTH * D * DFF * 2);
  p.Wg = (bf16_t*)take((size_t)DEPTH * 8 * 128 * 64 * 2);
  p.lb_all = (float*)take(2 * DEPTH * 512 * 4);
  p.SS = (float*)take((size_t)MT * 16 * 4);
  p.Xb = (bf16_t*)take((size_t)MT * D * 2);
  p.UH = (bf16_t*)take((size_t)MT * DFF * 2);
  p.Y = (bf16_t*)take((size_t)MT * D * 2);
  p.Pc = (bf16_t*)take((size_t)MP * 512 * 2);
  p.Hl = (bf16_t*)take((size_t)MP * 512 * 2);
  p.carry = (float*)take((size_t)NB * NCH * 512 * 4);
  p.Sbuf = (bf16_t*)take((size_t)32 * NCH * 16384 * 2);
  p.dec = (float*)take((size_t)32 * NCH * 128 * 4);
  p.bar = (unsigned*)take((size_t)XCD_BAR_WORDS * 4);
  if (off > ws_size) { fprintf(stderr, "workspace too small: need %zu have %zu\n", off, ws_size); return; }
#if MULTI_LAUNCH
  for (int ph = 0; ph < NPH; ++ph) hipLaunchKernelGGL(mega, dim3(grid_blocks), dim3(256), SMEM_ALLOC, stream, p, ph, ph + 1);
#else
  if (hipMemsetAsync(p.bar, 0, (size_t)XCD_BAR_WORDS * 4, stream) != hipSuccess) { fprintf(stderr, "memset failed\n"); return; }
  hipLaunchKernelGGL(mega, dim3(grid_blocks), dim3(256), SMEM_ALLOC, stream, p, 0, NPH);
#endif
}
```

```cpp
#include <hip/hip_runtime.h>
#include <hip/hip_cooperative_groups.h>
#include <cstdio>
namespace cg = cooperative_groups;
#define SKIPI 0

typedef unsigned short bf16_t;
typedef short bf16x8 __attribute__((ext_vector_type(8)));
typedef float f32x4 __attribute__((ext_vector_type(4)));
typedef unsigned u32x4 __attribute__((ext_vector_type(4)));

constexpr int D = 1024, TP = 2064, NB = 8, MP = NB * TP, MS = 512, MT = MP + MS, DEPTH = 4;
constexpr int INC = 3072, DFF = 4096, NCH = 33, SEQ = 2048, NMETA = 16;
constexpr int LDT = 80;
constexpr int LDQ = 144;
constexpr int SMEM_BYTES = 76800;
constexpr int SMEM_ALLOC = SMEM_BYTES + 16;
constexpr float EPSN = 1e-6f;

constexpr size_t O_YP = 0, O_YS = 16777216, O_HP = 17301504, O_CP = 17317888, O_SP = 17367040,
                 O_HS = 19464192, O_CS = 19726336, O_SS = 20512768;

struct Params {
  const float *x_prompt, *x_sample, *st_h, *st_conv, *st_S, *meta, *ln_mix, *w_in, *conv_w, *conv_b,
      *w_ra, *b_ra, *w_rx, *b_rx, *lam, *hgrn_lb, *gn, *w_out, *ln_mlp, *w_up, *w_down, *ln_final;
  float* out;
  bf16_t *Wt_in, *Wt_out, *Wt_up, *Wt_down, *Wg;
  float *lb_all, *SS;
  bf16_t *Xb, *UH, *Y;
  bf16_t *Pc, *Hl;
  float* carry;
  bf16_t* Sbuf;
  float* dec;
  unsigned* bar;
};

__device__ __forceinline__ int otid() { int t = threadIdx.x; asm volatile("" : "+v"(t)); return t; }
__device__ __forceinline__ float bf2f(bf16_t h) { return __uint_as_float(((unsigned)h) << 16); }
typedef float f32x2 __attribute__((ext_vector_type(2)));
typedef __bf16 bf16v2 __attribute__((ext_vector_type(2)));
__device__ __forceinline__ unsigned pk2(float lo, float hi) {
  const f32x2 v = {lo, hi};
  return __builtin_bit_cast(unsigned, __builtin_convertvector(v, bf16v2));
}
__device__ __forceinline__ bf16_t f2bf(float f) { return (bf16_t)(pk2(f, 0.f) & 0xffffu); }
__device__ __forceinline__ float frcp(float x) { return __builtin_amdgcn_rcpf(x); }
__device__ __forceinline__ float sigm(float x) { return frcp(1.f + __expf(-x)); }
__device__ __forceinline__ float silu(float x) { return x * sigm(x); }
__device__ __forceinline__ float gelu_t(float x) {
  float u = 0.7978845608028654f * (x + 0.044715f * x * x * x);
  return x * sigm(2.f * u);
}
__device__ __forceinline__ f32x4 mfma16(bf16x8 a, bf16x8 b, f32x4 c) {
  return __builtin_amdgcn_mfma_f32_16x16x32_bf16(a, b, c, 0, 0, 0);
}
__device__ __forceinline__ uint4 pack8(const float* v) {
  uint4 r;
  r.x = pk2(v[0], v[1]); r.y = pk2(v[2], v[3]); r.z = pk2(v[4], v[5]); r.w = pk2(v[6], v[7]);
  return r;
}


#define XB_TMO      128
#define XB_XCNT(j)  (256  + 64 * (j))
#define XB_XSUB(j)  (1280 + 64 * (j))
#define XB_XGEN(j)  (2304 + 64 * (j))
#define XB_TOP      3328
#define XB_TOPGEN   3392
#define XCD_BAR_WORDS 3456
#define XB_SPIN_CAP (1u << 20)
#define LAS __attribute__((address_space(3)))
__device__ __forceinline__ unsigned xb_ld(unsigned* p) { return __hip_atomic_load(p, __ATOMIC_RELAXED, __HIP_MEMORY_SCOPE_AGENT); }
__device__ __forceinline__ unsigned xb_add(unsigned* p, unsigned v) { return __hip_atomic_fetch_add(p, v, __ATOMIC_RELAXED, __HIP_MEMORY_SCOPE_AGENT); }
__device__ __forceinline__ unsigned xb_xcc_id() { return (unsigned)__builtin_amdgcn_s_getreg((3 << 11) | 20) & 0xFu; }
#define XB_SPIN(cond, bar) do { unsigned _sp = 0; while (cond) { __builtin_amdgcn_s_sleep(1); \
    if ((++_sp & 255u) == 0u) { if (xb_ld(&(bar)[XB_TMO])) break; if (_sp > XB_SPIN_CAP) { atomicAdd(&(bar)[XB_TMO], 1u); break; } } } } while (0)
struct XcdBarrier { unsigned* bar; unsigned x; volatile LAS unsigned* st; };
__device__ __forceinline__ XcdBarrier xcd_barrier_post(unsigned* bar, volatile LAS unsigned* st) {
  XcdBarrier b; b.bar = bar; b.x = xb_xcc_id(); b.st = st;
  if (threadIdx.x == 0) (void)xb_add(&bar[XB_XCNT(b.x)], 1u);
  return b;
}
__device__ __forceinline__ void xcd_barrier_complete(unsigned* bar, unsigned x, unsigned& nloc, unsigned& nx) {
  const unsigned G = gridDim.x * gridDim.y * gridDim.z;
  unsigned sum, cnt, mine, sp = 0u;
  for (;;) {
    sum = 0u; cnt = 0u; mine = 0u;
#pragma unroll
    for (unsigned j = 0; j < 16; ++j) { const unsigned c = xb_ld(&bar[XB_XCNT(j)]); sum += c; cnt += (c > 0u) ? 1u : 0u; mine = (j == x) ? c : mine; }
    if (sum == G) break;
    __builtin_amdgcn_s_sleep(1);
    if ((++sp & 255u) == 0u) { if (xb_ld(&bar[XB_TMO])) break; if (sp > XB_SPIN_CAP) { atomicAdd(&bar[XB_TMO], 1u); break; } }
  }
  nloc = mine > 0u ? mine : 1u; nx = cnt > 0u ? cnt : 1u;
}
__device__ __forceinline__ void xcd_barrier(const XcdBarrier& b) {
  asm volatile("s_waitcnt vmcnt(0)" ::: "memory");
  __syncthreads();
  if (threadIdx.x == 0) {
    unsigned* bar = b.bar;
    __builtin_amdgcn_s_waitcnt(0);
    unsigned nloc = b.st[0], nx = b.st[1];
    if (nloc == 0u) { xcd_barrier_complete(bar, b.x, nloc, nx); b.st[0] = nloc; b.st[1] = nx; }
    const unsigned old = xb_add(&bar[XB_XSUB(b.x)], 1u);
    const unsigned gen = old / nloc;
    if (old + 1u == (gen + 1u) * nloc) {
      __builtin_amdgcn_fence(__ATOMIC_RELEASE, "agent");
      asm volatile("s_waitcnt vmcnt(0)" ::: "memory");
      const unsigned og = xb_add(&bar[XB_TOP], 1u);
      const unsigned tg = og / nx;
      if (og + 1u == (tg + 1u) * nx) xb_add(&bar[XB_TOPGEN], 1u);
      else XB_SPIN(xb_ld(&bar[XB_TOPGEN]) == tg, bar);
      __builtin_amdgcn_fence(__ATOMIC_ACQUIRE, "agent");
      xb_add(&bar[XB_XGEN(b.x)], 1u);
      asm volatile("s_waitcnt vmcnt(0)" ::: "memory");
    } else {
      XB_SPIN(xb_ld(&bar[XB_XGEN(b.x)]) == gen, bar);
      __builtin_amdgcn_fence(__ATOMIC_ACQUIRE, "agent");
      asm volatile("s_waitcnt vmcnt(0)" ::: "memory");
    }
  }
  __syncthreads();
}

__device__ void transpose_item(const float* __restrict__ src, bf16_t* __restrict__ dst, const float* __restrict__ g,
                               int K, int N, int tk, int tn, float* Tf) {
  bf16_t* T = (bf16_t*)Tf;
  const int tid = otid();
  const int k0 = tk * 128, n0 = tn * 128;
  const int kr4 = (tid >> 5) * 4, nc = (tid & 31) * 4;
  __syncthreads();
#pragma unroll
  for (int hh = 0; hh < 2; ++hh) {
    f32x4 v[2][4];
#pragma unroll
    for (int h = 0; h < 2; ++h)
#pragma unroll
      for (int i = 0; i < 4; ++i) {
        const int kr = k0 + kr4 + 32 * (2 * hh + h) + i;
        v[h][i] = __builtin_nontemporal_load((const f32x4*)(src + (size_t)kr * N + n0 + nc));
        const float sc = g ? g[kr] : 1.f;
        v[h][i] *= sc;
      }
#pragma unroll
    for (int h = 0; h < 2; ++h)
#pragma unroll
      for (int j = 0; j < 4; ++j) {
        uint2 o; o.x = pk2(v[h][0][j], v[h][1][j]); o.y = pk2(v[h][2][j], v[h][3][j]);
        *(uint2*)(T + (nc + j) * 136 + kr4 + 32 * (2 * hh + h)) = o;
      }
  }
  __syncthreads();
#pragma unroll
  for (int j = 0; j < 8; ++j) {
    const int id = tid + 256 * j, n = id >> 4, c = id & 15;
    *(bf16x8*)(dst + (size_t)(n0 + n) * K + k0 + c * 8) = *(const bf16x8*)(T + n * 136 + c * 8);
  }
}

__device__ void phase_prologue(const Params& p, char* smem) {
  float* T = (float*)smem;
  const int G = gridDim.x, bid = blockIdx.x, tid = otid();
  constexpr int I_IN = DEPTH * 8 * 24, I_OUT = DEPTH * 8 * 8, I_UP = DEPTH * 8 * 32, I_DN = DEPTH * 32 * 8;
  constexpr int I_TOT = I_IN + I_OUT + I_UP + I_DN;
  for (int it = bid; it < I_TOT; it += G) {
    int i = it;
    if (i < I_IN) {
      int l = i / (8 * 24), r = i % (8 * 24);
      transpose_item(p.w_in + (size_t)l * D * INC, p.Wt_in + (size_t)l * D * INC, p.ln_mix + l * D, D, INC, r / 24, r % 24, T);
    } else if ((i -= I_IN) < I_OUT) {
      int l = i / 64, r = i % 64;
      transpose_item(p.w_out + (size_t)l * D * D, p.Wt_out + (size_t)l * D * D, nullptr, D, D, r / 8, r % 8, T);
    } else if ((i -= I_OUT) < I_UP) {
      int l = i / 256, r = i % 256;
      transpose_item(p.w_up + (size_t)l * D * DFF, p.Wt_up + (size_t)l * D * DFF, p.ln_mlp + l * D, D, DFF, r / 32, r % 32, T);
    } else {
      i -= I_UP;
      int l = i / 256, r = i % 256;
      transpose_item(p.w_down + (size_t)l * D * DFF, p.Wt_down + (size_t)l * D * DFF, nullptr, DFF, D, r / 8, r % 8, T);
    }
  }
  const int lane = tid & 63, wid = __builtin_amdgcn_readfirstlane(tid >> 6);
  for (int rg = bid; rg < MT / 4; rg += G) {
    int row = rg * 4 + wid;
    const float* src;
    if (row < MP) {
      int b = row / TP, t = row % TP;
      src = (t < NMETA) ? (p.meta + (size_t)t * D) : (p.x_prompt + ((size_t)b * SEQ + (t - NMETA)) * D);
    } else src = p.x_sample + (size_t)(row - MP) * D;
    float ss = 0.f;
#pragma unroll
    for (int i = 0; i < 2; ++i) {
      const int c = (i * 64 + lane) * 8;
      const f32x4 v0 = *(const f32x4*)(src + c), v1 = *(const f32x4*)(src + c + 4);
      const u32x4 o = {pk2(v0[0], v0[1]), pk2(v0[2], v0[3]), pk2(v1[0], v1[1]), pk2(v1[2], v1[3])};
      *(bf16x8*)(p.Xb + (size_t)row * D + c) = __builtin_bit_cast(bf16x8, o);
#pragma unroll
      for (int e = 0; e < 4; ++e) ss += v0[e] * v0[e] + v1[e] * v1[e];
    }
#pragma unroll
    for (int o = 32; o > 0; o >>= 1) ss += __shfl_xor(ss, o);
    if (lane < 16) p.SS[(size_t)row * 16 + lane] = (lane == 0) ? ss : 0.f;
  }
  for (int i = bid * 256 + tid; i < 512; i += G * 256) {
    float v0 = p.hgrn_lb[i], v1 = p.hgrn_lb[512 + i], v2 = p.hgrn_lb[1024 + i], v3 = p.hgrn_lb[1536 + i];
    float m = fmaxf(fmaxf(v0, v1), fmaxf(v2, v3));
    float e0 = expf(v0 - m), e1 = expf(v1 - m), e2 = expf(v2 - m), e3 = expf(v3 - m);
    float inv = 1.f / (e0 + e1 + e2 + e3);
    float s1 = e1 * inv, s2 = e2 * inv, s3 = e3 * inv;
    p.lb_all[i] = 0.f;
#pragma unroll
    for (int l = 0; l < DEPTH; ++l) p.lb_all[2048 + l * 512 + i] = log1pf(expf(-p.lam[l * 512 + i]));
    p.lb_all[512 + i] = fminf(fmaxf(s1, 0.f), 1.f);
    p.lb_all[1024 + i] = fminf(fmaxf(s1 + s2, 0.f), 1.f);
    p.lb_all[1536 + i] = fminf(fmaxf(s1 + s2 + s3, 0.f), 1.f);
  }
  for (int i = bid * 256 + tid; i < DEPTH * 8 * 128 * 64; i += G * 256) {
    int ii = i & 63, j = (i >> 6) & 127, lh = i >> 13;
    float v = (j < 64) ? p.w_ra[(size_t)lh * 4096 + ii * 64 + j] : p.w_rx[(size_t)lh * 4096 + ii * 64 + (j - 64)];
    p.Wg[i] = f2bf(v);
  }
}

enum { EPI_U = 0, EPI_UP = 1, EPI_RES = 2 };

template <int EPI, int RS>
__device__ void gemm_phase(const Params& p, const bf16_t* __restrict__ A, const bf16_t* __restrict__ Bt, int K, int N, bf16_t* Obf, char* smem_) {
  const int ntn = N >> 7, ntiles = (MT >> 7) * ntn;
  const int tid = otid(), lane = tid & 63, wid = __builtin_amdgcn_readfirstlane(tid >> 6), wr = wid >> 1, wc = wid & 1, fr = lane & 15, fq = lane >> 4;
  bf16_t* As = (bf16_t*)smem_;
  bf16_t* Bs = As + 2 * 128 * 64;
  const int lrow = tid >> 3;
  const int cg = ((tid & 7) ^ ((lrow >> 1) & 7)) * 8;
  const int sw0 = (fq ^ (fr >> 1)) * 8;
  const size_t rstep = (size_t)32 * K;
  const int nk = K >> 6;
  constexpr int CS = 8 / RS;
  const int xcd = blockIdx.x & 7, slots = gridDim.x >> 3, ncx = ntn / CS;
#define G_TM(J) (RS * ((J) / ncx) + (xcd % RS))
#define G_TN(J) (CS * ((J) % ncx) + (xcd / RS))
  int tile = blockIdx.x >> 3;
  if (G_TM(tile) >= (MT >> 7)) return;
  const bf16_t* ga = A + (size_t)(G_TM(tile) * 128 + lrow) * K + cg;
  const int lrowp = 8 * ((lrow & 15) >> 2) + 4 * (lrow >> 4) + (lrow & 3);
  const bf16_t* gb = Bt + (size_t)(G_TN(tile) * 128 + lrowp) * K + cg;
#define G_DMA(BUF, KT) { const int ko_ = (KT) * 64; __builtin_amdgcn_s_setprio(2); _Pragma("unroll") for (int i = 0; i < 4; ++i) { \
    __builtin_amdgcn_global_load_lds((const unsigned*)(ga + i * rstep + ko_), (LAS unsigned*)(As + (BUF) * 8192 + i * 2048 + tid * 8), 16, 0, 0); \
    __builtin_amdgcn_global_load_lds((const unsigned*)(gb + i * rstep + ko_), (LAS unsigned*)(Bs + (BUF) * 8192 + i * 2048 + tid * 8), 16, 0, 0); } __builtin_amdgcn_s_setprio(0); }
#define G_SB __builtin_amdgcn_sched_barrier(0)
#define G_A(MI, SO) (*(const bf16x8*)(as + (MI) * 16 * 64 + (SO)))
#define G_B(NI, SO) (*(const bf16x8*)(bs + (NI) * 16 * 64 + (SO)))
#define G_ROW(BF, MI) { _Pragma("unroll") for (int ni = 0; ni < 4; ++ni) acc[MI][ni] = mfma16(BF[ni], af[MI], acc[MI][ni]); }
#define G_COMPUTE(BUF) { const bf16_t* as = As + (BUF) * 128 * 64 + (wr * 64 + fr) * 64; const bf16_t* bs = Bs + (BUF) * 128 * 64 + (wc * 64 + fr) * 64; \
    const int so0 = sw0, so1 = sw0 ^ 32; bf16x8 af[4], b0[4], b1[4]; \
    _Pragma("unroll") for (int mi = 0; mi < 4; ++mi) af[mi] = G_A(mi, so0); \
    _Pragma("unroll") for (int ni = 0; ni < 4; ++ni) b0[ni] = G_B(ni, so0); \
    G_SB; __builtin_amdgcn_s_setprio(1); \
    G_ROW(b0, 0); G_SB; b1[0] = G_B(0, so1); b1[1] = G_B(1, so1); af[0] = G_A(0, so1); G_SB; \
    G_ROW(b0, 1); G_SB; b1[2] = G_B(2, so1); b1[3] = G_B(3, so1); af[1] = G_A(1, so1); G_SB; \
    G_ROW(b0, 2); G_SB; af[2] = G_A(2, so1); G_SB; \
    G_ROW(b0, 3); G_SB; af[3] = G_A(3, so1); G_SB; \
    G_ROW(b1, 0); G_ROW(b1, 1); G_ROW(b1, 2); G_ROW(b1, 3); \
    __builtin_amdgcn_s_setprio(0); }
  G_DMA(0, 0);
  __syncthreads();
  for (;;) {
    const int tm = G_TM(tile), tn = G_TN(tile);
    const int m0 = tm * 128, n0 = tn * 128;
    f32x4 acc[4][4];
#pragma unroll
    for (int mi = 0; mi < 4; ++mi)
#pragma unroll
      for (int ni = 0; ni < 4; ++ni) acc[mi][ni] = (f32x4){0.f, 0.f, 0.f, 0.f};
    for (int kt = 0; kt + 2 < nk; kt += 2) {
      G_DMA(1, kt + 1);
      G_SB;
      G_COMPUTE(0);
      __syncthreads();
      G_DMA(0, kt + 2);
      G_SB;
      G_COMPUTE(1);
      __syncthreads();
    }
    const int next = tile + slots;
    const bool more = G_TM(next) < (MT >> 7);
    const int nx = more ? next : tile;
    G_DMA(1, nk - 1);
    G_SB;
    G_COMPUTE(0);
    __syncthreads();
    ga = A + (size_t)(G_TM(nx) * 128 + lrow) * K + cg;
    gb = Bt + (size_t)(G_TN(nx) * 128 + lrowp) * K + cg;
    G_DMA(0, 0);
    G_SB;
    G_COMPUTE(1);
    __syncthreads();
#pragma unroll
    for (int mi = 0; mi < 4; ++mi) {
      const int row = m0 + wr * 64 + mi * 16 + fr;
      const int colb = n0 + wc * 64 + fq * 8;
      if (EPI == EPI_U || EPI == EPI_UP) {
        const f32x4 st = *((const f32x4*)(p.SS + (size_t)row * 16) + fq);
        float ss = (st[0] + st[1]) + (st[2] + st[3]);
        ss += __shfl_xor(ss, 16);
        ss += __shfl_xor(ss, 32);
        float sc = rsqrtf(ss * (1.f / D) + EPSN);
#pragma unroll
        for (int g = 0; g < 2; ++g) {
          f32x4 v0 = acc[mi][2 * g] * sc, v1 = acc[mi][2 * g + 1] * sc;
          if (EPI == EPI_UP) {
#pragma unroll
            for (int j = 0; j < 4; ++j) { float r0 = fmaxf(v0[j], 0.f), r1 = fmaxf(v1[j], 0.f); v0[j] = r0 * r0; v1[j] = r1 * r1; }
          }
          const u32x4 o = {pk2(v0[0], v0[1]), pk2(v0[2], v0[3]), pk2(v1[0], v1[1]), pk2(v1[2], v1[3])};
          *(bf16x8*)(Obf + (size_t)row * N + colb + g * 32) = __builtin_bit_cast(bf16x8, o);
        }
      } else {
        float part = 0.f;
#pragma unroll
        for (int g = 0; g < 2; ++g) {
          bf16_t* xp = p.Xb + (size_t)row * D + colb + g * 32;
          const bf16x8 xw = *(const bf16x8*)xp;
          f32x4 x0 = acc[mi][2 * g], x1 = acc[mi][2 * g + 1];
#pragma unroll
          for (int j = 0; j < 4; ++j) { x0[j] += bf2f((bf16_t)xw[j]); x1[j] += bf2f((bf16_t)xw[4 + j]); }
          const u32x4 o = {pk2(x0[0], x0[1]), pk2(x0[2], x0[3]), pk2(x1[0], x1[1]), pk2(x1[2], x1[3])};
          *(bf16x8*)xp = __builtin_bit_cast(bf16x8, o);
#pragma unroll
          for (int j = 0; j < 4; ++j) part += x0[j] * x0[j] + x1[j] * x1[j];
        }
        part += __shfl_xor(part, 16);
        part += __shfl_xor(part, 32);
        if (fq == 0) p.SS[(size_t)row * 16 + tn * 2 + wc] = part;
      }
    }
    if (!more) break;
    tile = next;
  }
#undef G_TM
#undef G_TN
#undef G_DMA
#undef G_COMPUTE
#undef G_SB
#undef G_A
#undef G_B
#undef G_ROW
}

template <bool SAMPLE>
__device__ void rg_item(const Params& p, int l, int item, char* smem) {
  float* XC = (float*)smem;
  float* AA = XC + 64 * 68;
  bf16_t* XA = (bf16_t*)(AA + 64 * 68);
  float* AG = (float*)(XA + 64 * LDT);
  const int tid = otid(), lane = tid & 63, wid = __builtin_amdgcn_readfirstlane(tid >> 6), fr = lane & 15, fq = lane >> 4;
  int hd, b = 0, c = 0, rb = 0, t0 = 0;
  if (SAMPLE) { hd = item & 7; rb = item >> 3; }
  else { hd = item & 7; int r = item >> 3; c = r % NCH; b = r / NCH; t0 = 64 * c - 48; }
  const bf16_t* U = p.UH;
  bf16x8 wfr[2][8];
  {
    const bf16_t* wg = p.Wg + (size_t)(l * 8 + hd) * 128 * 64;
#pragma unroll
    for (int kk = 0; kk < 2; ++kk)
#pragma unroll
      for (int ib = 0; ib < 8; ++ib) wfr[kk][ib] = *(const bf16x8*)(wg + (ib * 16 + fr) * 64 + kk * 32 + fq * 8);
  }
  f32x4 pbra[4], pbrx[4], plm[4];
#pragma unroll
  for (int ib = 0; ib < 4; ++ib) {
    const int chp = hd * 64 + ib * 16 + fq * 4;
    pbra[ib] = *(const f32x4*)(p.b_ra + l * 512 + chp);
    pbrx[ib] = *(const f32x4*)(p.b_rx + l * 512 + chp);
    plm[ib] = *(const f32x4*)(p.lb_all + 2048 + l * 512 + chp);
  }
  bf16_t* RAW = (bf16_t*)AA;
  bf16x8 rraw[3];
  if (!SAMPLE) {
#pragma unroll
    for (int i = 0; i < 3; ++i) {
      const int id = tid + 256 * i, rr = id >> 3, t = t0 - 3 + rr;
      const bf16x8 z = {0, 0, 0, 0, 0, 0, 0, 0};
      rraw[i] = (id < 67 * 8 && t >= 0) ? *(const bf16x8*)(U + ((size_t)b * TP + (t >= 0 ? t : 0)) * INC + hd * 64 + (id & 7) * 8) : z;
    }
  }
  float* RAWF = (float*)(smem + 47104);
  bf16_t* RAWU = (bf16_t*)(smem + 59392);
  bf16_t* RAWG = (bf16_t*)(smem + 67584);
  f32x4 rsf[3]; bf16x8 rsu[2], rsg[2];
  if (SAMPLE) {
#pragma unroll
    for (int i = 0; i < 3; ++i) {
      const int id = tid + 256 * i, r = id >> 4, c4 = (id & 15) * 4;
      rsf[i] = *(const f32x4*)(p.st_conv + ((size_t)(l * 128 + rb * 16) * 3 + r) * 512 + hd * 64 + c4);
    }
#pragma unroll
    for (int i = 0; i < 2; ++i) {
      const int id = tid + 256 * i, r = id >> 3, c8 = (id & 7) * 8;
      const bf16_t* ur = U + ((size_t)MP + rb * 64 + r) * INC + hd * 64 + c8;
      rsu[i] = *(const bf16x8*)ur;
      rsg[i] = *(const bf16x8*)(ur + 512);
    }
  }
  __syncthreads();
  if (!SAMPLE) {
#pragma unroll
    for (int i = 0; i < 3; ++i) {
      const int id = tid + 256 * i;
      if (id < 67 * 8) *(bf16x8*)(RAW + (id >> 3) * 72 + (id & 7) * 8) = rraw[i];
    }
    __syncthreads();
  } else {
#pragma unroll
    for (int i = 0; i < 3; ++i) { const int id = tid + 256 * i; *(f32x4*)(RAWF + (id >> 4) * 64 + (id & 15) * 4) = rsf[i]; }
#pragma unroll
    for (int i = 0; i < 2; ++i) { const int id = tid + 256 * i; *(bf16x8*)(RAWU + (id >> 3) * 64 + (id & 7) * 8) = rsu[i]; *(bf16x8*)(RAWG + (id >> 3) * 64 + (id & 7) * 8) = rsg[i]; }
    __syncthreads();
  }
  {
    const int i = tid & 63, tq = tid >> 6, ch = hd * 64 + i;
    const float cw0 = p.conv_w[(l * 4 + 0) * 512 + ch], cw1 = p.conv_w[(l * 4 + 1) * 512 + ch],
                cw2 = p.conv_w[(l * 4 + 2) * 512 + ch], cw3 = p.conv_w[(l * 4 + 3) * 512 + ch], cb = p.conv_b[l * 512 + ch];
    if (!SAMPLE) {
      const bf16_t* R = RAW + (tq * 16) * 72 + i;
      float x0 = bf2f(R[0]), x1 = bf2f(R[72]), x2 = bf2f(R[144]);
#pragma unroll
      for (int j = 0; j < 16; ++j) {
        float x3 = bf2f(R[(j + 3) * 72]);
        float xc = cb + cw0 * x0 + cw1 * x1 + cw2 * x2 + cw3 * x3;
        XC[(tq * 16 + j) * 68 + i] = xc;
        XA[(tq * 16 + j) * LDT + i] = f2bf(xc);
        x0 = x1; x1 = x2; x2 = x3;
      }
    } else {
#pragma unroll
      for (int bi = 0; bi < 4; ++bi) {
        const int sq = tq * 4 + bi;
        float x0 = RAWF[(sq * 3 + 0) * 64 + i], x1 = RAWF[(sq * 3 + 1) * 64 + i], x2 = RAWF[(sq * 3 + 2) * 64 + i];
#pragma unroll
        for (int t = 0; t < 4; ++t) {
          float x3 = bf2f(RAWU[(sq * 4 + t) * 64 + i]);
          float xc = cb + cw0 * x0 + cw1 * x1 + cw2 * x2 + cw3 * x3;
          int tt = tq * 16 + bi * 4 + t;
          XC[tt * 68 + i] = xc;
          XA[tt * LDT + i] = f2bf(xc);
          x0 = x1; x1 = x2; x2 = x3;
        }
      }
    }
  }
  __syncthreads();
  {
    f32x4 acc[8];
#pragma unroll
    for (int ib = 0; ib < 8; ++ib) acc[ib] = (f32x4){0.f, 0.f, 0.f, 0.f};
#pragma unroll
    for (int kk = 0; kk < 2; ++kk) {
      bf16x8 xb = *(const bf16x8*)(XA + (wid * 16 + fr) * LDT + kk * 32 + fq * 8);
#pragma unroll
      for (int ib = 0; ib < 8; ++ib) acc[ib] = mfma16(wfr[kk][ib], xb, acc[ib]);
    }
    const int tt = wid * 16 + fr;
    bool valid = SAMPLE ? true : (t0 + tt >= 0);
#pragma unroll
    for (int ib = 0; ib < 4; ++ib) {
      const int cl = ib * 16 + fq * 4, ch = hd * 64 + cl;
      const f32x4 bra = pbra[ib], brx = pbrx[ib], lm = plm[ib];
      f32x4 xc = *(const f32x4*)(XC + tt * 68 + cl);
      f32x4 av, bv;
#pragma unroll
      for (int j = 0; j < 4; ++j) {
        float rg = sigm(acc[ib][j] + bra[j]);
        float ig = sigm(acc[ib + 4][j] + brx[j]);
        float la = -8.f * rg * lm[j];
        float a = __expf(la);
        float t2 = 2.f * la;
        float om = (t2 > -0.1f) ? -t2 * (1.f + t2 * (0.5f + t2 * (0.16666667f + t2 * 0.041666668f))) : 1.f - __expf(t2);
        float bt = __builtin_amdgcn_sqrtf(fmaxf(om, 0.f)) * ig * xc[j];
        av[j] = valid ? a : 1.f;
        bv[j] = valid ? bt : 0.f;
      }
      *(f32x4*)(AA + tt * 68 + cl) = av;
      *(f32x4*)(XC + tt * 68 + cl) = bv;
    }
  }
  __syncthreads();
  const int cc = tid & 63, q = tid >> 6, ch = hd * 64 + cc;
  if (!SAMPLE) {
    float P = 1.f, h = 0.f;
#pragma unroll
    for (int j = 0; j < 16; ++j) {
      int tt = q * 16 + j;
      float a = AA[tt * 68 + cc], bt = XC[tt * 68 + cc];
      h = a * h + bt; P *= a;
      AA[tt * 68 + cc] = P; XC[tt * 68 + cc] = h;
    }
    AG[(q * 64 + cc) * 2] = P; AG[(q * 64 + cc) * 2 + 1] = h;
    __syncthreads();
    float Pin = 1.f, hin = 0.f;
    for (int qq = 0; qq < q; ++qq) {
      float Pq = AG[(qq * 64 + cc) * 2], hq = AG[(qq * 64 + cc) * 2 + 1];
      hin = Pq * hin + hq; Pin *= Pq;
    }
#pragma unroll
    for (int j = 0; j < 16; ++j) {
      const int tt = q * 16 + j;
      const float Pl = AA[tt * 68 + cc], hl = XC[tt * 68 + cc];
      AA[tt * 68 + cc] = Pl * Pin;
      XC[tt * 68 + cc] = hl + Pl * hin;
    }
    __syncthreads();
#pragma unroll
    for (int j = 0; j < 2; ++j) {
      const int id = tid + 256 * j, tt = id >> 3, c8 = (id & 7) * 8, t = t0 + tt;
      if (t >= 0) {
        const f32x4 pa = *(const f32x4*)(AA + tt * 68 + c8), pb = *(const f32x4*)(AA + tt * 68 + c8 + 4);
        const f32x4 ha = *(const f32x4*)(XC + tt * 68 + c8), hb = *(const f32x4*)(XC + tt * 68 + c8 + 4);
        const size_t o = ((size_t)b * TP + t) * 512 + hd * 64 + c8;
        const u32x4 po = {pk2(pa[0], pa[1]), pk2(pa[2], pa[3]), pk2(pb[0], pb[1]), pk2(pb[2], pb[3])};
        const u32x4 ho = {pk2(ha[0], ha[1]), pk2(ha[2], ha[3]), pk2(hb[0], hb[1]), pk2(hb[2], hb[3])};
        *(bf16x8*)(p.Pc + o) = __builtin_bit_cast(bf16x8, po);
        *(bf16x8*)(p.Hl + o) = __builtin_bit_cast(bf16x8, ho);
      }
    }
  } else {
#pragma unroll
    for (int bi = 0; bi < 4; ++bi) {
      const int bs = rb * 16 + q * 4 + bi;
      float h = p.st_h[(size_t)(l * 128 + bs) * 512 + ch];
#pragma unroll
      for (int t = 0; t < 4; ++t) {
        const int tt = q * 16 + bi * 4 + t;
        h = AA[tt * 68 + cc] * h + XC[tt * 68 + cc];
        XC[tt * 68 + cc] = h;
      }
    }
    __syncthreads();
#pragma unroll
    for (int j = 0; j < 2; ++j) {
      const int id = tid + 256 * j, tt = id >> 3, c8 = (id & 7) * 8, t = tt & 3, bs = rb * 16 + (tt >> 2);
      const f32x4 ha = *(const f32x4*)(XC + tt * 68 + c8), hb = *(const f32x4*)(XC + tt * 68 + c8 + 4);
      const bf16x8 gv = *(const bf16x8*)(RAWG + tt * 64 + c8), uv = *(const bf16x8*)(RAWU + tt * 64 + c8);
      float y[8];
#pragma unroll
      for (int e = 0; e < 4; ++e) { y[e] = ha[e] * gelu_t(bf2f((bf16_t)gv[e])); y[4 + e] = hb[e] * gelu_t(bf2f((bf16_t)gv[4 + e])); }
      const u32x4 yo = {pk2(y[0], y[1]), pk2(y[2], y[3]), pk2(y[4], y[5]), pk2(y[6], y[7])};
      *(bf16x8*)(p.Y + ((size_t)MP + rb * 64 + tt) * D + hd * 64 + c8) = __builtin_bit_cast(bf16x8, yo);
      if (t >= 1) {
        float* o = p.out + O_CS + ((size_t)(l * 128 + bs) * 3 + (t - 1)) * 512 + hd * 64 + c8;
        const f32x4 u0 = {bf2f((bf16_t)uv[0]), bf2f((bf16_t)uv[1]), bf2f((bf16_t)uv[2]), bf2f((bf16_t)uv[3])};
        const f32x4 u1 = {bf2f((bf16_t)uv[4]), bf2f((bf16_t)uv[5]), bf2f((bf16_t)uv[6]), bf2f((bf16_t)uv[7])};
        *(f32x4*)o = u0; *(f32x4*)(o + 4) = u1;
      }
      if (t == 3) {
        float* o = p.out + O_HS + (size_t)(l * 128 + bs) * 512 + hd * 64 + c8;
        *(f32x4*)o = ha; *(f32x4*)(o + 4) = hb;
      }
    }
  }
}

__device__ __forceinline__ void hgrn_fk(const bf16_t* __restrict__ Ub, int t0h, float lbv, float (&cs)[32], float (&kv)[32], float& run) {
  run = 0.f;
#pragma unroll
  for (int i = 0; i < 32; ++i) {
    int t = t0h + i;
    bool valid = t >= 0;
    float fpre = valid ? bf2f(Ub[(size_t)(valid ? t : 0) * INC]) : 0.f;
    float e = __expf(fminf(-fpre, 80.f));
    float sg = frcp(1.f + e);
    float f = lbv + (1.f - lbv) * sg;
    float lf = valid ? __logf(fmaxf(f, 1e-30f)) : 0.f;
    float kk = valid ? (1.f - lbv) * (e * sg) : 0.f;
    run += lf; cs[i] = run; kv[i] = kk;
  }
}

__device__ __forceinline__ void hgrn_load_vt(const bf16_t* __restrict__ Uv, int t0h, bf16_t* Vt, int v, int half) {
#pragma unroll
  for (int g = 0; g < 4; ++g) {
    unsigned w[4];
#pragma unroll
    for (int e = 0; e < 4; ++e) {
      int ta = t0h + g * 8 + e * 2, tb = ta + 1;
      unsigned lo = (ta >= 0) ? (unsigned)Uv[(size_t)(ta >= 0 ? ta : 0) * INC] : 0u;
      unsigned hi = (tb >= 0) ? (unsigned)Uv[(size_t)(tb >= 0 ? tb : 0) * INC] : 0u;
      w[e] = lo | (hi << 16);
    }
    uint4 o; o.x = w[0]; o.y = w[1]; o.z = w[2]; o.w = w[3];
    *(uint4*)(Vt + v * LDT + half * 32 + g * 8) = o;
  }
}

__device__ __forceinline__ void load_tile_regs(const bf16_t* __restrict__ Ucol, int t0, int tid, bf16x8 (&r)[4]) {
#pragma unroll
  for (int i = 0; i < 4; ++i) {
    const int id = tid + 256 * i, row = id >> 4, ch = (id & 15) * 8, t = t0 + row;
    const bf16x8 z = {0, 0, 0, 0, 0, 0, 0, 0};
    r[i] = (t >= 0) ? *(const bf16x8*)(Ucol + (size_t)(t >= 0 ? t : 0) * INC + ch) : z;
  }
}
__device__ __forceinline__ void store_tile_regs(bf16_t* L, int tid, const bf16x8 (&r)[4]) {
#pragma unroll
  for (int i = 0; i < 4; ++i) {
    const int id = tid + 256 * i, row = id >> 4, ch = (id & 15) * 8;
    *(bf16x8*)(L + row * LDQ + ch) = r[i];
  }
}
__device__ __forceinline__ void hgrn_fk_lds(const bf16_t* Fcol, int t0h, float lbv, float (&fv)[32], float (&kv)[32]) {
#pragma unroll
  for (int i = 0; i < 32; ++i) {
    const bool valid = (t0h + i) >= 0;
    float fpre = bf2f(Fcol[i * LDQ]);
    float e = __expf(fminf(-fpre, 80.f));
    float sg = frcp(1.f + e);
    float f = fmaxf(lbv + (1.f - lbv) * sg, 1e-30f);
    fv[i] = valid ? f : 1.f;
    kv[i] = valid ? (1.f - lbv) * (e * sg) : 0.f;
  }
}

__device__ void hgrn_local(const Params& p, int l, int item, char* smem) {
  bf16_t* Kt = (bf16_t*)smem;
  bf16_t* Fr = Kt;
  bf16_t* Vt = Kt + 128 * LDT;
  bf16_t* Vr = Vt;
  float* tots = (float*)(Vt + 128 * LDT);
  const int tid = otid(), lane = tid & 63, wid = __builtin_amdgcn_readfirstlane(tid >> 6), fr = lane & 15, fq = lane >> 4;
  const int c = item % NCH, bh = item / NCH, h = bh & 3, b = bh >> 2;
  const int t0 = 64 * c - 48;
  const int k = tid & 127, half = tid >> 7;
  const bf16_t* Ub = p.UH + (size_t)b * TP * INC;
  {
    bf16x8 rf[4], rv[4];
    load_tile_regs(Ub + 1536 + h * 128, t0, tid, rf);
    load_tile_regs(Ub + 2048 + h * 128, t0, tid, rv);
    __syncthreads();
    store_tile_regs(Fr, tid, rf);
    store_tile_regs(Vr, tid, rv);
  }
  const float lbv = p.lb_all[l * 512 + h * 128 + k];
  __syncthreads();
  float fv[32], kv[32];
  hgrn_fk_lds(Fr + (half * 32) * LDQ + k, t0 + half * 32, lbv, fv, kv);
  float run = 1.f;
#pragma unroll
  for (int i = 31; i >= 0; --i) { kv[i] *= run; run *= fv[i]; }
  tots[half * 128 + k] = run;
  unsigned vw[16];
#pragma unroll
  for (int e = 0; e < 16; ++e) {
    const int ta = half * 32 + e * 2;
    vw[e] = (unsigned)Vr[ta * LDQ + k] | ((unsigned)Vr[(ta + 1) * LDQ + k] << 16);
  }
  __syncthreads();
  const float after = (half == 0) ? tots[128 + k] : 1.f;
  if (half == 0) p.dec[((size_t)bh * NCH + c) * 128 + k] = run * after;
#pragma unroll
  for (int g = 0; g < 4; ++g) {
    float v[8];
#pragma unroll
    for (int e = 0; e < 8; ++e) v[e] = kv[g * 8 + e] * after;
    const u32x4 ko = {pk2(v[0], v[1]), pk2(v[2], v[3]), pk2(v[4], v[5]), pk2(v[6], v[7])};
    *(bf16x8*)(Kt + k * LDT + half * 32 + g * 8) = __builtin_bit_cast(bf16x8, ko);
    const u32x4 vo = {vw[g * 4 + 0], vw[g * 4 + 1], vw[g * 4 + 2], vw[g * 4 + 3]};
    *(bf16x8*)(Vt + k * LDT + half * 32 + g * 8) = __builtin_bit_cast(bf16x8, vo);
  }
  __syncthreads();
  f32x4 acc[8][2];
#pragma unroll
  for (int ib = 0; ib < 8; ++ib) { acc[ib][0] = (f32x4){0.f, 0.f, 0.f, 0.f}; acc[ib][1] = (f32x4){0.f, 0.f, 0.f, 0.f}; }
#pragma unroll
  for (int kk = 0; kk < 2; ++kk) {
    bf16x8 vb0 = *(const bf16x8*)(Vt + (wid * 32 + fr) * LDT + kk * 32 + fq * 8);
    bf16x8 vb1 = *(const bf16x8*)(Vt + (wid * 32 + 16 + fr) * LDT + kk * 32 + fq * 8);
#pragma unroll
    for (int ib = 0; ib < 8; ++ib) {
      bf16x8 ka = *(const bf16x8*)(Kt + (32 * (ib >> 1) + 8 * (fr >> 2) + 4 * (ib & 1) + (fr & 3)) * LDT + kk * 32 + fq * 8);
      acc[ib][0] = mfma16(ka, vb0, acc[ib][0]);
      acc[ib][1] = mfma16(ka, vb1, acc[ib][1]);
    }
  }
  bf16_t* Sb = p.Sbuf + ((size_t)bh * NCH + c) * 16384;
#pragma unroll
  for (int g = 0; g < 4; ++g)
#pragma unroll
    for (int jn = 0; jn < 2; ++jn) {
      const int v = wid * 32 + jn * 16 + fr, kb = 32 * g + 8 * fq;
      const f32x4 a0 = acc[2 * g][jn], a1 = acc[2 * g + 1][jn];
      const u32x4 o = {pk2(a0[0], a0[1]), pk2(a0[2], a0[3]), pk2(a1[0], a1[1]), pk2(a1[2], a1[3])};
      *(bf16x8*)(Sb + v * 128 + kb) = __builtin_bit_cast(bf16x8, o);
    }
}

__device__ void hgrn_out(const Params& p, int l, int item, char* smem) {
  bf16_t* Qs = (bf16_t*)smem;
  bf16_t* Ks = Qs + 64 * LDQ;
  bf16_t* Vt = Ks + 64 * LDQ;
  bf16_t* Am = Vt + 128 * LDT;
  bf16_t* Vr = Am;
  float* eref = (float*)(Vr + 64 * LDQ);
  const int tid = otid(), lane = tid & 63, wid = __builtin_amdgcn_readfirstlane(tid >> 6), fr = lane & 15, fq = lane >> 4;
  const int c = item % NCH, bh = item / NCH, h = bh & 3, b = bh >> 2;
  const int t0 = 64 * c - 48;
  const int k = tid & 127, half = tid >> 7;
  const bf16_t* Ub = p.UH + (size_t)b * TP * INC;
  const bf16_t* Sb = p.Sbuf + ((size_t)bh * NCH + c) * 16384;
  const int tw = wid * 16 + fr;
  {
    bf16x8 rq[4], rf[4], rv[4];
    load_tile_regs(Ub + 1024 + h * 128, t0, tid, rq);
    load_tile_regs(Ub + 1536 + h * 128, t0, tid, rf);
    load_tile_regs(Ub + 2048 + h * 128, t0, tid, rv);
    __syncthreads();
    store_tile_regs(Qs, tid, rq);
    store_tile_regs(Ks, tid, rf);
    store_tile_regs(Vr, tid, rv);
  }
  const float lbv = p.lb_all[l * 512 + h * 128 + k];
  __syncthreads();
  {
    float fv[32], kv[32];
    hgrn_fk_lds(Ks + (half * 32) * LDQ + k, t0 + half * 32, lbv, fv, kv);
    if (half == 0) {
      float R = 1.f;
#pragma unroll
      for (int i = 31; i >= 0; --i) { const float Rc = fmaxf(R, 1e-30f); const float kk = kv[i]; kv[i] = kk * Rc; R *= fv[i]; fv[i] = frcp(Rc); }
      eref[k] = R;
    } else {
      float F = 1.f;
#pragma unroll
      for (int i = 0; i < 32; ++i) { F *= fv[i]; const float Fc = fmaxf(F, 1e-30f); fv[i] = Fc; kv[i] *= frcp(Fc); }
    }
#pragma unroll
    for (int i = 0; i < 32; ++i) {
      const bool valid = (t0 + half * 32 + i) >= 0;
      float qb = bf2f(Qs[(half * 32 + i) * LDQ + k]);
      float qv = valid ? silu(qb) * 0.08838834764831845f : 0.f;
      Qs[(half * 32 + i) * LDQ + k] = f2bf(qv * fv[i]);
      Ks[(half * 32 + i) * LDQ + k] = f2bf(kv[i]);
    }
#pragma unroll
    for (int g = 0; g < 4; ++g) {
      unsigned w[4];
#pragma unroll
      for (int e = 0; e < 4; ++e) {
        const int ta = half * 32 + g * 8 + e * 2;
        w[e] = (unsigned)Vr[ta * LDQ + k] | ((unsigned)Vr[(ta + 1) * LDQ + k] << 16);
      }
      const u32x4 o = {w[0], w[1], w[2], w[3]};
      *(bf16x8*)(Vt + k * LDT + half * 32 + g * 8) = __builtin_bit_cast(bf16x8, o);
    }
  }
#define VROW(IB) (32 * ((IB) >> 1) + 8 * (fr >> 2) + 4 * ((IB) & 1) + (fr & 3))
  bf16x8 sf0[8], sf1[8];
#pragma unroll
  for (int ib = 0; ib < 8; ++ib) {
    sf0[ib] = *(const bf16x8*)(Sb + VROW(ib) * 128 + fq * 8);
    sf1[ib] = *(const bf16x8*)(Sb + VROW(ib) * 128 + 32 + fq * 8);
  }
  __syncthreads();
  f32x4 acc[8];
#pragma unroll
  for (int ib = 0; ib < 8; ++ib) acc[ib] = (f32x4){0.f, 0.f, 0.f, 0.f};
  bf16x8 qf[4];
#pragma unroll
  for (int kk = 0; kk < 4; ++kk) qf[kk] = *(const bf16x8*)(Qs + tw * LDQ + kk * 32 + fq * 8);
  {
#pragma unroll
    for (int ib = 0; ib < 4; ++ib) {
      f32x4 a = (f32x4){0.f, 0.f, 0.f, 0.f};
      if (ib <= wid) {
#pragma unroll
        for (int kk = 0; kk < 4; ++kk) {
          bf16x8 kf = *(const bf16x8*)(Ks + (ib * 16 + fr) * LDQ + kk * 32 + fq * 8);
          a = mfma16(kf, qf[kk], a);
        }
      }
      const int sb = ib * 16 + fq * 4;
      float a0 = (sb + 0 <= tw) ? a[0] : 0.f, a1 = (sb + 1 <= tw) ? a[1] : 0.f, a2 = (sb + 2 <= tw) ? a[2] : 0.f, a3 = (sb + 3 <= tw) ? a[3] : 0.f;
      if (ib > wid) { a0 = 0.f; a1 = 0.f; a2 = 0.f; a3 = 0.f; }
      uint2 o; o.x = pk2(a0, a1); o.y = pk2(a2, a3);
      *(uint2*)(Am + tw * LDT + sb) = o;
    }
  }
#define QHAT(KK, QH) { const f32x4* er = (const f32x4*)(eref + (KK) * 32 + fq * 8); const f32x4 e0 = er[0], e1 = er[1]; float qv_[8]; \
    _Pragma("unroll") for (int e = 0; e < 8; ++e) qv_[e] = bf2f((bf16_t)qf[KK][e]) * (e < 4 ? e0[e & 3] : e1[e & 3]); \
    const u32x4 pq_ = {pk2(qv_[0], qv_[1]), pk2(qv_[2], qv_[3]), pk2(qv_[4], qv_[5]), pk2(qv_[6], qv_[7])}; QH = __builtin_bit_cast(bf16x8, pq_); }
  {
    bf16x8 qh;
    QHAT(0, qh);
#pragma unroll
    for (int ib = 0; ib < 8; ++ib) acc[ib] = mfma16(sf0[ib], qh, acc[ib]);
    QHAT(1, qh);
#pragma unroll
    for (int ib = 0; ib < 8; ++ib) acc[ib] = mfma16(sf1[ib], qh, acc[ib]);
  }
#pragma unroll
  for (int ib = 0; ib < 8; ++ib) {
    sf0[ib] = *(const bf16x8*)(Sb + VROW(ib) * 128 + 64 + fq * 8);
    sf1[ib] = *(const bf16x8*)(Sb + VROW(ib) * 128 + 96 + fq * 8);
  }
  const int tg = t0 + tw;
  const size_t row = (size_t)b * TP + (tg >= 0 ? tg : 0);
  bf16x8 gw[4];
#pragma unroll
  for (int g = 0; g < 4; ++g) gw[g] = *(const bf16x8*)(p.UH + row * INC + 2560 + h * 128 + 32 * g + 8 * fq);
  __syncthreads();
  {
#pragma unroll
    for (int kk = 0; kk < 2; ++kk) {
      bf16x8 af = *(const bf16x8*)(Am + tw * LDT + kk * 32 + fq * 8);
#pragma unroll
      for (int ib = 0; ib < 8; ++ib) {
        bf16x8 vf = *(const bf16x8*)(Vt + VROW(ib) * LDT + kk * 32 + fq * 8);
        acc[ib] = mfma16(vf, af, acc[ib]);
      }
    }
    bf16x8 qh;
    QHAT(2, qh);
#pragma unroll
    for (int ib = 0; ib < 8; ++ib) acc[ib] = mfma16(sf0[ib], qh, acc[ib]);
    QHAT(3, qh);
#pragma unroll
    for (int ib = 0; ib < 8; ++ib) acc[ib] = mfma16(sf1[ib], qh, acc[ib]);
    float ss = 0.f;
#pragma unroll
    for (int ib = 0; ib < 8; ++ib) ss += acc[ib][0] * acc[ib][0] + acc[ib][1] * acc[ib][1] + acc[ib][2] * acc[ib][2] + acc[ib][3] * acc[ib][3];
    ss += __shfl_xor(ss, 16);
    ss += __shfl_xor(ss, 32);
    const float sc = rsqrtf(ss * (1.f / 128.f) + EPSN);
    if (tg >= 0) {
#pragma unroll
      for (int g = 0; g < 4; ++g) {
        const int v = 32 * g + 8 * fq;
        const f32x4 gn0 = *(const f32x4*)(p.gn + l * 128 + v), gn1 = *(const f32x4*)(p.gn + l * 128 + v + 4);
        float y[8];
#pragma unroll
        for (int e = 0; e < 4; ++e) {
          y[e] = acc[2 * g][e] * sc * gn0[e] * silu(bf2f((bf16_t)gw[g][e]));
          y[4 + e] = acc[2 * g + 1][e] * sc * gn1[e] * silu(bf2f((bf16_t)gw[g][4 + e]));
        }
        const u32x4 o = {pk2(y[0], y[1]), pk2(y[2], y[3]), pk2(y[4], y[5]), pk2(y[6], y[7])};
        *(bf16x8*)(p.Y + row * D + 512 + h * 128 + v) = __builtin_bit_cast(bf16x8, o);
      }
    }
  }
#undef VROW
#undef QHAT
}

__device__ void hgrn_sample(const Params& p, int l, int item, char* smem) {
  float* qf = (float*)smem;
  float* ff = qf + 512;
  float* kf = ff + 512;
  float* PO = kf + 512;
  const int tid = otid(), lane = tid & 63, wid = __builtin_amdgcn_readfirstlane(tid >> 6);
  const int h = item & 3, bs = item >> 2;
  const int kq = tid >> 5, v4 = (tid & 31) * 4;
  const size_t sbase = ((size_t)(l * 128 + bs) * 4 + h) * 16384;
  const size_t row0 = (size_t)MP + bs * 4;
  __syncthreads();
  f32x4 S[16];
#pragma unroll
  for (int r = 0; r < 16; ++r) S[r] = __builtin_nontemporal_load((const f32x4*)(p.st_S + sbase + (size_t)(kq * 16 + r) * 128 + v4));
#pragma unroll
  for (int j = 0; j < 2; ++j) {
    int idx = tid + 256 * j, t = idx >> 7, k = idx & 127;
    const bf16_t* ur = p.UH + (row0 + t) * INC + h * 128 + k;
    float qb = bf2f(ur[1024]), fpre = bf2f(ur[1536]);
    float lbv = p.lb_all[l * 512 + h * 128 + k];
    float e = __expf(fminf(-fpre, 80.f));
    float sg = frcp(1.f + e);
    qf[idx] = silu(qb) * 0.08838834764831845f;
    ff[idx] = fmaxf(lbv + (1.f - lbv) * sg, 1e-30f);
    kf[idx] = (1.f - lbv) * (e * sg);
  }
  __syncthreads();
#pragma unroll
  for (int t = 0; t < 4; ++t) {
    uint2 vw = *(const uint2*)(p.UH + (row0 + t) * INC + 2048 + h * 128 + v4);
    f32x4 vt = (f32x4){__uint_as_float(vw.x << 16), __uint_as_float(vw.x & 0xffff0000u), __uint_as_float(vw.y << 16), __uint_as_float(vw.y & 0xffff0000u)};
    f32x4 po = (f32x4){0.f, 0.f, 0.f, 0.f};
#pragma unroll
    for (int r = 0; r < 16; ++r) {
      int k = kq * 16 + r;
      float f = ff[t * 128 + k], kk = kf[t * 128 + k], q = qf[t * 128 + k];
      S[r] = S[r] * f + vt * kk;
      po += S[r] * q;
    }
    *(f32x4*)(PO + (kq * 4 + t) * 128 + v4) = po;
  }
#pragma unroll
  for (int r = 0; r < 16; ++r) __builtin_nontemporal_store(S[r], (f32x4*)(p.out + O_SS + sbase + (size_t)(kq * 16 + r) * 128 + v4));
  __syncthreads();
  {
    const int t = wid;
    float o0 = 0.f, o1 = 0.f;
#pragma unroll
    for (int g = 0; g < 8; ++g) { o0 += PO[(g * 4 + t) * 128 + lane]; o1 += PO[(g * 4 + t) * 128 + 64 + lane]; }
    float ss = o0 * o0 + o1 * o1;
#pragma unroll
    for (int o = 32; o > 0; o >>= 1) ss += __shfl_xor(ss, o);
    const float sc = rsqrtf(ss * (1.f / 128.f) + EPSN);
    const size_t row = row0 + t;
    float g0 = bf2f(p.UH[row * INC + 2560 + h * 128 + lane]), g1 = bf2f(p.UH[row * INC + 2560 + h * 128 + 64 + lane]);
    p.Y[row * D + 512 + h * 128 + lane] = f2bf(o0 * sc * p.gn[l * 128 + lane] * silu(g0));
    p.Y[row * D + 512 + h * 128 + 64 + lane] = f2bf(o1 * sc * p.gn[l * 128 + 64 + lane] * silu(g1));
  }
}

__device__ void mixer_local(const Params& p, int l, char* smem) {
  constexpr int N_RGP = NB * NCH * 8, N_HL = 32 * NCH;
  constexpr int TOT = N_RGP + N_HL;
  for (int it = blockIdx.x; it < TOT; it += gridDim.x) {
    int i = it;
    if (i < N_HL) hgrn_local(p, l, i, smem);
    else rg_item<false>(p, l, i - N_HL, smem);
  }
}

__device__ void mixer_carry(const Params& p, int l, char* smem) {
  const int G = gridDim.x, bid = blockIdx.x, tid = otid();
  for (int it = bid; it < 256 + 16 + 512 + 64; it += G) {
    if (it >= 272 + 512) rg_item<true>(p, l, it - 272 - 512, smem);
    else if (it >= 272) hgrn_sample(p, l, it - 272, smem);
    else if (it < 256) {
      int gt = it * 256 + tid;
      int bh = gt >> 11, e = gt & 2047, v = e >> 4, k8 = (e & 15) * 8;
      float S[8];
#pragma unroll
      for (int j = 0; j < 8; ++j) S[j] = 0.f;
      bf16_t* sb = p.Sbuf + (size_t)bh * NCH * 16384 + v * 128 + k8;
      const float* dc = p.dec + (size_t)bh * NCH * 128 + k8;
      uint4 lwv[NCH];
#pragma unroll
      for (int c = 0; c < NCH; ++c) lwv[c] = *(const uint4*)(sb + (size_t)c * 16384);
#pragma unroll
      for (int c = 0; c < NCH; ++c) {
        const uint4 lw = lwv[c];
        f32x4 d0 = *(const f32x4*)(dc + c * 128), d1 = *(const f32x4*)(dc + c * 128 + 4);
        *(uint4*)(sb + (size_t)c * 16384) = pack8(S);
        S[0] = S[0] * d0[0] + __uint_as_float(lw.x << 16); S[1] = S[1] * d0[1] + __uint_as_float(lw.x & 0xffff0000u);
        S[2] = S[2] * d0[2] + __uint_as_float(lw.y << 16); S[3] = S[3] * d0[3] + __uint_as_float(lw.y & 0xffff0000u);
        S[4] = S[4] * d1[0] + __uint_as_float(lw.z << 16); S[5] = S[5] * d1[1] + __uint_as_float(lw.z & 0xffff0000u);
        S[6] = S[6] * d1[2] + __uint_as_float(lw.w << 16); S[7] = S[7] * d1[3] + __uint_as_float(lw.w & 0xffff0000u);
      }
      float* o = p.out + O_SP + ((size_t)(l * 32 + bh)) * 16384;
#pragma unroll
      for (int j = 0; j < 8; ++j) o[(size_t)(k8 + j) * 128 + v] = S[j];
    } else {
      int gt = (it - 256) * 256 + tid;
      int b = gt >> 9, ch = gt & 511;
      float carry = 0.f;
      float Pl[NCH], hl[NCH];
#pragma unroll
      for (int c = 0; c < NCH; ++c) {
        size_t row = (size_t)b * TP + 15 + 64 * c;
        Pl[c] = bf2f(p.Pc[row * 512 + ch]); hl[c] = bf2f(p.Hl[row * 512 + ch]);
      }
#pragma unroll
      for (int c = 0; c < NCH; ++c) {
        p.carry[((size_t)b * NCH + c) * 512 + ch] = carry;
        carry = Pl[c] * carry + hl[c];
      }
      p.out[O_HP + (size_t)(l * 8 + b) * 512 + ch] = carry;
#pragma unroll
      for (int j = 0; j < 3; ++j)
        p.out[O_CP + ((size_t)(l * 8 + b) * 3 + j) * 512 + ch] = bf2f(p.UH[((size_t)b * TP + TP - 3 + j) * INC + ch]);
    }
  }
}

__device__ void mixer_out(const Params& p, int l, char* smem) {
  constexpr int N_HO = 32 * NCH, N_RO = MP / 16;
  for (int it = blockIdx.x; it < N_HO + N_RO; it += gridDim.x) {
    if (it < N_HO) hgrn_out(p, l, it, smem);
    else {
      const int r0 = (it - N_HO) * 16;
      const int tid = otid();
#pragma unroll
      for (int j = 0; j < 4; ++j) {
        const int idx = tid + 256 * j;
        const int row = r0 + (idx >> 6), ch = (idx & 63) * 8;
        const int b = row / TP, t = row % TP, c = (t + 48) >> 6;
        const bf16x8 pw = *(const bf16x8*)(p.Pc + (size_t)row * 512 + ch), hw = *(const bf16x8*)(p.Hl + (size_t)row * 512 + ch);
        const bf16x8 gw = *(const bf16x8*)(p.UH + (size_t)row * INC + 512 + ch);
        const f32x4 c0 = *(const f32x4*)(p.carry + ((size_t)b * NCH + c) * 512 + ch), c1 = *(const f32x4*)(p.carry + ((size_t)b * NCH + c) * 512 + ch + 4);
        float y[8];
#pragma unroll
        for (int e = 0; e < 8; ++e) {
          const float hv = bf2f((bf16_t)hw[e]) + bf2f((bf16_t)pw[e]) * (e < 4 ? c0[e & 3] : c1[e & 3]);
          y[e] = hv * gelu_t(bf2f((bf16_t)gw[e]));
        }
        const u32x4 o = {pk2(y[0], y[1]), pk2(y[2], y[3]), pk2(y[4], y[5]), pk2(y[6], y[7])};
        *(bf16x8*)(p.Y + (size_t)row * D + ch) = __builtin_bit_cast(bf16x8, o);
      }
    }
  }
}

__device__ void phase_final(const Params& p) {
  const int tid = otid(), lane = tid & 63, wid = __builtin_amdgcn_readfirstlane(tid >> 6);
  for (int rg = blockIdx.x; rg < MT / 4; rg += gridDim.x) {
    int row = rg * 4 + wid;
    float* dst;
    if (row < MP) {
      int b = row / TP, t = row % TP;
      if (t < NMETA) continue;
      dst = p.out + O_YP + ((size_t)b * SEQ + (t - NMETA)) * D;
    } else dst = p.out + O_YS + (size_t)(row - MP) * D;
    float v[2][8];
    float ss = 0.f;
#pragma unroll
    for (int i = 0; i < 2; ++i) {
      const bf16x8 xw = *(const bf16x8*)(p.Xb + (size_t)row * D + (i * 64 + lane) * 8);
#pragma unroll
      for (int e = 0; e < 8; ++e) { v[i][e] = bf2f((bf16_t)xw[e]); ss += v[i][e] * v[i][e]; }
    }
#pragma unroll
    for (int o = 32; o > 0; o >>= 1) ss += __shfl_xor(ss, o);
    float sc = rsqrtf(ss * (1.f / D) + EPSN);
#pragma unroll
    for (int i = 0; i < 2; ++i) {
      const int c = (i * 64 + lane) * 8;
      const f32x4 g0 = *(const f32x4*)(p.ln_final + c), g1 = *(const f32x4*)(p.ln_final + c + 4);
      const f32x4 o0 = {v[i][0] * sc * g0[0], v[i][1] * sc * g0[1], v[i][2] * sc * g0[2], v[i][3] * sc * g0[3]};
      const f32x4 o1 = {v[i][4] * sc * g1[0], v[i][5] * sc * g1[1], v[i][6] * sc * g1[2], v[i][7] * sc * g1[3]};
      __builtin_nontemporal_store(o0, (f32x4*)(dst + c));
      __builtin_nontemporal_store(o1, (f32x4*)(dst + c + 4));
    }
  }
}

#ifndef SKIPI
#define SKIPI 0
#endif
#define RS_IN 2
#define RS_OUT 2
#define RS_UP 2
#define RS_DN 4
#ifndef PROBE_ML
#define PROBE_ML 1
#define PROBE_MO 1
#define PROBE_PR 1
#endif
#ifndef PROBE_REP
#define PROBE_REP 1
#endif
#ifndef MULTI_LAUNCH
#define MULTI_LAUNCH 0
#endif
constexpr int NPH = 2 + 7 * DEPTH;
__global__ void __launch_bounds__(256, 2) mega(Params p, int ph_lo, int ph_hi) {
  extern __shared__ __attribute__((aligned(16))) char smem[];
  volatile LAS unsigned* xbw = (volatile LAS unsigned*)(smem + SMEM_BYTES);
  if (threadIdx.x < 4) xbw[threadIdx.x] = 0u;
  __syncthreads();
  XcdBarrier xb = xcd_barrier_post(p.bar, xbw);
  for (int ph = ph_lo; ph < ph_hi; ++ph) {
    if (ph == 0) { for (int rep = 0; rep < PROBE_PR; ++rep) phase_prologue(p, smem); }
    else if (ph == NPH - 1) phase_final(p);
    else {
      const int l = (ph - 1) / 7, j = (ph - 1) % 7;
#ifdef SKIP_MASK
      if ((SKIP_MASK >> j) & 1) continue;
#endif
      switch (j) {
        case 0: for (int rep = 0; rep < PROBE_REP; ++rep) gemm_phase<EPI_U, RS_IN>(p, p.Xb, p.Wt_in + (size_t)l * D * INC, D, INC, p.UH, smem); break;
        case 1: for (int rep = 0; rep < PROBE_ML; ++rep) mixer_local(p, l, smem); break;
        case 2: mixer_carry(p, l, smem); break;
        case 3: for (int rep = 0; rep < PROBE_MO; ++rep) mixer_out(p, l, smem); break;
        case 4: gemm_phase<EPI_RES, RS_OUT>(p, p.Y, p.Wt_out + (size_t)l * D * D, D, D, nullptr, smem); break;
        case 5: for (int rep = 0; rep < PROBE_REP; ++rep) gemm_phase<EPI_UP, RS_UP>(p, p.Xb, p.Wt_up + (size_t)l * D * DFF, D, DFF, p.UH, smem); break;
        default: gemm_phase<EPI_RES, RS_DN>(p, p.UH, p.Wt_down + (size_t)l * D * DFF, DFF, D, nullptr, smem); break;
      }
    }
    if (ph + 1 < ph_hi) xcd_barrier(xb);
  }
}

extern "C" void kernel_launch(void* const* d_in, const int* in_sizes, int n_in, void* d_out, int out_size, void* d_ws, size_t ws_size,
                              hipStream_t stream) {
  static int grid_blocks = 0;
  if (!grid_blocks) {
    int dev = 0, cus = 0, per_cu = 0;
    hipGetDevice(&dev);
    hipDeviceGetAttribute(&cus, hipDeviceAttributeMultiprocessorCount, dev);
    hipFuncSetAttribute((const void*)mega, hipFuncAttributeMaxDynamicSharedMemorySize, SMEM_ALLOC);
    hipOccupancyMaxActiveBlocksPerMultiprocessor(&per_cu, mega, 256, SMEM_ALLOC);
    if (per_cu > 2) per_cu = 2;
    if (per_cu < 1) per_cu = 1;
    grid_blocks = (cus * per_cu) & ~7;
  }
  Params p{};
  const float* const* in = (const float* const*)d_in;
  p.x_prompt = in[0]; p.x_sample = in[1]; p.st_h = in[2]; p.st_conv = in[3]; p.st_S = in[4]; p.meta = in[5]; p.ln_mix = in[6];
  p.w_in = in[7]; p.conv_w = in[8]; p.conv_b = in[9]; p.w_ra = in[10]; p.b_ra = in[11]; p.w_rx = in[12]; p.b_rx = in[13];
  p.lam = in[14]; p.hgrn_lb = in[15]; p.gn = in[16]; p.w_out = in[17]; p.ln_mlp = in[18]; p.w_up = in[19]; p.w_down = in[20];
  p.ln_final = in[21];
  p.out = (float*)d_out;
  char* w = (char*)d_ws;
  size_t off = 0;
  auto take = [&](size_t bytes) { char* r = w + off; off += (bytes + 255) & ~(size_t)255; return r; };
  p.Wt_in = (bf16_t*)take((size_t)DEPTH * D * INC * 2);
  p.Wt_out = (bf16_t*)take((size_t)DEPTH * D * D * 2);
  p.Wt_up = (bf16_t*)take((size_t)DEPTH * D * DFF * 2);
  p.Wt_down = (bf16_t*)take((size_t)DEPTH * D * DFF * 2);
  p.Wg = (bf16_t*)take((size_t)DEPTH * 8 * 128 * 64 * 2);
  p.lb_all = (float*)take(2 * DEPTH * 512 * 4);
  p.SS = (float*)take((size_t)MT * 16 * 4);
  p.Xb = (bf16_t*)take((size_t)MT * D * 2);
  p.UH = (bf16_t*)take((size_t)MT * DFF * 2);
  p.Y = (bf16_t*)take((size_t)MT * D * 2);
  p.Pc = (bf16_t*)take((size_t)MP * 512 * 2);
  p.Hl = (bf16_t*)take((size_t)MP * 512 * 2);
  p.carry = (float*)take((size_t)NB * NCH * 512 * 4);
  p.Sbuf = (bf16_t*)take((size_t)32 * NCH * 16384 * 2);
  p.dec = (float*)take((size_t)32 * NCH * 128 * 4);
  p.bar = (unsigned*)take((size_t)XCD_BAR_WORDS * 4);
  if (off > ws_size) { fprintf(stderr, "workspace too small: need %zu have %zu\n", off, ws_size); return; }
#if MULTI_LAUNCH
  for (int ph = 0; ph < NPH; ++ph) hipLaunchKernelGGL(mega, dim3(grid_blocks), dim3(256), SMEM_ALLOC, stream, p, ph, ph + 1);
#else
  if (hipMemsetAsync(p.bar, 0, (size_t)XCD_BAR_WORDS * 4, stream) != hipSuccess) { fprintf(stderr, "memset failed\n"); return; }
  hipLaunchKernelGGL(mega, dim3(grid_blocks), dim3(256), SMEM_ALLOC, stream, p, 0, NPH);
#endif
}
```
